# Optimizing an MI355X kernel written in HIP

```python
import math
import jax, jax.numpy as jnp
from jax import lax
import numpy as np

D_MODEL = 1024
BATCH = 4
SEQ = 8192
DEPTH = 4
DEC_BATCH = 4
DEC_SEQ = 4096
PAST_LEN = 128

N_MIXERS = 2
N_LAYERS_A = (DEPTH + 1) // 2
N_LAYERS_B = DEPTH // 2

DA_HEADS = 8
DA_HEAD_DIM = 64
DA_V_DIM = 2 * DA_HEAD_DIM
DA_QK_WIDTH = DA_HEADS * DA_HEAD_DIM
DA_OUT_WIDTH = DA_HEADS * DA_V_DIM
DA_IN_WIDTH = 4 * DA_QK_WIDTH + DA_OUT_WIDTH
Q_BLOCK = 128

DIL_PATTERNS = ((128, 1), (512, 4), (2048, 16))
DIL_GROUPS = len(DIL_PATTERNS)
DIL_HEADS = 16
DIL_HEAD_DIM = 64
DIL_GROUP_WIDTH = DIL_HEADS * DIL_HEAD_DIM
DIL_IN_WIDTH = DIL_GROUPS * 3 * DIL_GROUP_WIDTH

ROPE_THETA = 500000.0
ROPE_FRACTION_DIV = 4

LN_EPS = 1e-5
DEEPNORM_ALPHA = (2.0 * DEPTH) ** 0.25
DEEPNORM_BETA = (8.0 * DEPTH) ** -0.25

MOE_GROUPS = 4
MOE_EXPERTS = 4
MOE_TOP_K = 2
MOE_FF = 512

NEG_INF = -1e30

kernel_name = 'hybrid_diff_dilated_hmoe_encoder'


def layer_norm(x, g, b):
    xf = x.astype(jnp.float32)
    mu = jnp.mean(xf, axis=-1, keepdims=True)
    var = jnp.mean(jnp.square(xf - mu), axis=-1, keepdims=True)
    y = (xf - mu) * lax.rsqrt(var + LN_EPS) * g.astype(jnp.float32) + b.astype(jnp.float32)
    return y.astype(x.dtype)


def partial_rope(x):
    S, dh = x.shape[1], x.shape[-1]
    rot = dh // ROPE_FRACTION_DIV
    half = rot // 2
    inv = ROPE_THETA ** (-jnp.arange(half, dtype=jnp.float32) * (2.0 / rot))
    ang = jnp.arange(S, dtype=jnp.float32)[:, None] * inv[None, :]
    cos = jnp.cos(ang)[None, :, None, :]
    sin = jnp.sin(ang)[None, :, None, :]
    xr = x[..., :rot].astype(jnp.float32)
    x1, x2 = xr[..., :half], xr[..., half:]
    r = jnp.concatenate([x1 * cos - x2 * sin, x2 * cos + x1 * sin], axis=-1).astype(x.dtype)
    return jnp.concatenate([r, x[..., rot:]], axis=-1)


def diff_attention(x, w_in, w_out, lam_q1, lam_k1, lam_q2, lam_k2, subln_g, lambda_init):
    B, S, _ = x.shape
    H, dh = DA_HEADS, DA_HEAD_DIM
    nblk = S // Q_BLOCK
    proj = x @ w_in
    W = DA_QK_WIDTH
    q1, q2, k1, k2, v = jnp.split(proj, [W, 2 * W, 3 * W, 4 * W], axis=-1)
    hd = lambda t: partial_rope(t.reshape(B, S, H, dh))
    q = jnp.stack([hd(q1), hd(q2)], axis=0)
    k = jnp.stack([hd(k1), hd(k2)], axis=0).transpose(0, 1, 3, 2, 4)
    v = v.reshape(B, S, H, DA_V_DIM).transpose(0, 2, 1, 3)
    lam = (jnp.exp(jnp.sum(lam_q1.astype(jnp.float32) * lam_k1.astype(jnp.float32)))
           - jnp.exp(jnp.sum(lam_q2.astype(jnp.float32) * lam_k2.astype(jnp.float32)))
           + lambda_init)
    scale = dh ** -0.5
    qb = q.reshape(2, B, nblk, Q_BLOCK, H, dh).transpose(2, 0, 1, 4, 3, 5)

    def block(qblk):
        s = jnp.einsum('mbhqd,mbhkd->mbhqk', qblk, k).astype(jnp.float32) * scale
        p = jax.nn.softmax(s, axis=-1)
        a = p[0] - lam * p[1]
        return jnp.einsum('bhqk,bhkd->bhqd', a.astype(v.dtype), v)

    o = lax.map(block, qb)
    o = o.transpose(1, 0, 3, 2, 4).reshape(B, S, H, DA_V_DIM)
    of = o.astype(jnp.float32)
    of = of * lax.rsqrt(jnp.mean(jnp.square(of), axis=-1, keepdims=True) + LN_EPS)
    of = of * subln_g.astype(jnp.float32) * (1.0 - lambda_init)
    return of.astype(x.dtype).reshape(B, S, DA_OUT_WIDTH) @ w_out


def dilated_group(q, k, v, dilation, half):
    B, S, H, dh = q.shape
    L = S // dilation
    nb = -(-L // half)
    Lp = nb * half

    def to_sub(t, extra):
        t = t.reshape(B, L, dilation, H, dh).transpose(0, 2, 1, 3, 4)
        return jnp.pad(t, ((0, 0), (0, 0), (extra, Lp - L + extra), (0, 0), (0, 0)))

    def neighbours(t):
        return jnp.concatenate([t[:, :, :-2], t[:, :, 1:-1], t[:, :, 2:]], axis=3)

    qs = to_sub(q, 0).reshape(B, dilation, nb, half, H, dh)
    kw = neighbours(to_sub(k, half).reshape(B, dilation, nb + 2, half, H, dh))
    vw = neighbours(to_sub(v, half).reshape(B, dilation, nb + 2, half, H, dh))
    s = jnp.einsum('brnqhd,brnkhd->brnhqk', qs, kw).astype(jnp.float32) * (dh ** -0.5)
    qi = jnp.arange(half)[:, None]
    kj = jnp.arange(3 * half)[None, :]
    rel = kj - half - qi
    kpos = (jnp.arange(nb)[:, None, None] - 1) * half + kj[None]
    valid = (jnp.abs(rel) <= half)[None] & (kpos >= 0) & (kpos < L)
    s = jnp.where(valid[None, None, :, None], s, NEG_INF)
    lse = jax.nn.logsumexp(s, axis=-1)
    p = jnp.exp(s - lse[..., None])
    o = jnp.einsum('brnhqk,brnkhd->brnqhd', p.astype(v.dtype), vw)
    o = o.reshape(B, dilation, Lp, H, dh)[:, :, :L].transpose(0, 2, 1, 3, 4).reshape(B, S, H, dh)
    lse = lse.transpose(0, 1, 2, 4, 3).reshape(B, dilation, Lp, H)[:, :, :L]
    lse = lse.transpose(0, 2, 1, 3).reshape(B, S, H)
    return o, lse


def dilated_attention(x, w_in, w_out):
    B, S, _ = x.shape
    G, H, dh = DIL_GROUPS, DIL_HEADS, DIL_HEAD_DIM
    proj = (x @ w_in).reshape(B, S, G, 3, H, dh)
    q = partial_rope(proj[:, :, :, 0].reshape(B, S, G * H, dh)).reshape(B, S, G, H, dh)
    k = partial_rope(proj[:, :, :, 1].reshape(B, S, G * H, dh)).reshape(B, S, G, H, dh)
    v = proj[:, :, :, 2]
    outs, lses = [], []
    for g, (window, dilation) in enumerate(DIL_PATTERNS):
        half = window // (2 * dilation)
        o, l = dilated_group(q[:, :, g], k[:, :, g], v[:, :, g], dilation, half)
        outs.append(o)
        lses.append(l)
    wts = jax.nn.softmax(jnp.stack(lses, axis=0), axis=0)
    o = jnp.sum(wts[..., None].astype(v.dtype) * jnp.stack(outs, axis=0), axis=0)
    return o.reshape(B, S, DIL_GROUP_WIDTH) @ w_out


def hier_moe(x, w_router_group, w_router_expert, w_gate, w_up, w_down):
    B, S, D = x.shape
    t = x.reshape(B * S, D)
    gp = jax.nn.softmax((t @ w_router_group).astype(jnp.float32), axis=-1)
    gw, gsel = lax.top_k(gp, 1)
    gmask = jax.nn.one_hot(gsel[:, 0], MOE_GROUPS, dtype=jnp.float32)
    el = jnp.einsum('td,dge->tge', t, w_router_expert).astype(jnp.float32)
    el_sel = jnp.einsum('tge,tg->te', el, gmask)
    topv, topi = lax.top_k(el_sel, MOE_TOP_K)
    tw = jax.nn.softmax(topv, axis=-1) * gw
    ew = jnp.sum(jax.nn.one_hot(topi, MOE_EXPERTS, dtype=jnp.float32) * tw[..., None], axis=1)
    combine = gmask[:, :, None] * ew[:, None, :]
    y = jnp.zeros_like(t)
    for g in range(MOE_GROUPS):
        h = jax.nn.silu(jnp.einsum('td,edf->tef', t, w_gate[g])) * jnp.einsum('td,edf->tef', t, w_up[g])
        h = h * combine[:, g, :, None].astype(h.dtype)
        y = y + jnp.einsum('tef,efd->td', h, w_down[g])
    return y.reshape(B, S, D)


def trunk(x, da_w_in, da_w_out, da_lambda_q1, da_lambda_k1, da_lambda_q2, da_lambda_k2, da_subln_g,
          dl_w_in, dl_w_out, ln1_g, ln1_b, ln2_g, ln2_b,
          moe_router_group, moe_router_expert, moe_w_gate, moe_w_up, moe_w_down):
    for i in range(DEPTH):
        j = i // N_MIXERS
        if i % N_MIXERS == 0:
            lambda_init = 0.8 - 0.6 * math.exp(-0.3 * i)
            h = diff_attention(x, da_w_in[j], da_w_out[j], da_lambda_q1[j], da_lambda_k1[j],
                               da_lambda_q2[j], da_lambda_k2[j], da_subln_g[j], lambda_init)
        else:
            h = dilated_attention(x, dl_w_in[j], dl_w_out[j])
        x = layer_norm(DEEPNORM_ALPHA * x + h, ln1_g[i], ln1_b[i])
        f = hier_moe(x, moe_router_group[i], moe_router_expert[i], moe_w_gate[i], moe_w_up[i], moe_w_down[i])
        x = layer_norm(DEEPNORM_ALPHA * x + f, ln2_g[i], ln2_b[i])
    return x


def setup_inputs(seed: int = 0) -> dict:
    key = jax.random.key(seed)
    ks = jax.random.split(key, 24)
    nrm = lambda k, shape: jax.random.normal(k, shape, dtype=jnp.float32)
    D = D_MODEL
    beta = DEEPNORM_BETA
    da_col = jnp.concatenate([jnp.ones((4 * DA_QK_WIDTH,), jnp.float32),
                              jnp.full((DA_OUT_WIDTH,), beta, jnp.float32)])
    dl_col = jnp.ones((DIL_GROUPS, 3, DIL_GROUP_WIDTH), jnp.float32).at[:, 2].set(beta).reshape(-1)
    return {
        'x_prompt': nrm(ks[0], (BATCH, SEQ, D)),
        'x_sample': nrm(ks[1], (DEC_BATCH, DEC_SEQ, D)),
        'da_w_in': nrm(ks[2], (N_LAYERS_A, D, DA_IN_WIDTH)) * (D ** -0.5) * da_col,
        'da_w_out': nrm(ks[3], (N_LAYERS_A, DA_OUT_WIDTH, D)) * (DA_OUT_WIDTH ** -0.5) * beta,
        'da_lambda_q1': nrm(ks[4], (N_LAYERS_A, DA_HEAD_DIM)) * 0.1,
        'da_lambda_k1': nrm(ks[5], (N_LAYERS_A, DA_HEAD_DIM)) * 0.1,
        'da_lambda_q2': nrm(ks[6], (N_LAYERS_A, DA_HEAD_DIM)) * 0.1,
        'da_lambda_k2': nrm(ks[7], (N_LAYERS_A, DA_HEAD_DIM)) * 0.1,
        'da_subln_g': 1.0 + 0.02 * nrm(ks[8], (N_LAYERS_A, DA_V_DIM)),
        'dl_w_in': nrm(ks[9], (N_LAYERS_B, D, DIL_IN_WIDTH)) * (D ** -0.5) * dl_col,
        'dl_w_out': nrm(ks[10], (N_LAYERS_B, DIL_GROUP_WIDTH, D)) * (DIL_GROUP_WIDTH ** -0.5) * beta,
        'ln1_g': 1.0 + 0.02 * nrm(ks[11], (DEPTH, D)),
        'ln1_b': 0.02 * nrm(ks[12], (DEPTH, D)),
        'ln2_g': 1.0 + 0.02 * nrm(ks[13], (DEPTH, D)),
        'ln2_b': 0.02 * nrm(ks[14], (DEPTH, D)),
        'moe_router_group': nrm(ks[15], (DEPTH, D, MOE_GROUPS)) * (D ** -0.5),
        'moe_router_expert': nrm(ks[16], (DEPTH, D, MOE_GROUPS, MOE_EXPERTS)) * (D ** -0.5),
        'moe_w_gate': nrm(ks[17], (DEPTH, MOE_GROUPS, MOE_EXPERTS, D, MOE_FF)) * (D ** -0.5),
        'moe_w_up': nrm(ks[18], (DEPTH, MOE_GROUPS, MOE_EXPERTS, D, MOE_FF)) * (D ** -0.5) * beta,
        'moe_w_down': nrm(ks[19], (DEPTH, MOE_GROUPS, MOE_EXPERTS, MOE_FF, D)) * (MOE_FF ** -0.5) * beta,
    }


def reference(x_prompt, x_sample, da_w_in, da_w_out, da_lambda_q1, da_lambda_k1, da_lambda_q2,
              da_lambda_k2, da_subln_g, dl_w_in, dl_w_out, ln1_g, ln1_b, ln2_g, ln2_b,
              moe_router_group, moe_router_expert, moe_w_gate, moe_w_up, moe_w_down):
    y_prompt = trunk(x_prompt, da_w_in, da_w_out, da_lambda_q1, da_lambda_k1, da_lambda_q2, da_lambda_k2,
                     da_subln_g, dl_w_in, dl_w_out, ln1_g, ln1_b, ln2_g, ln2_b,
                     moe_router_group, moe_router_expert, moe_w_gate, moe_w_up, moe_w_down)
    y_sample = trunk(x_sample, da_w_in, da_w_out, da_lambda_q1, da_lambda_k1, da_lambda_q2, da_lambda_k2,
                     da_subln_g, dl_w_in, dl_w_out, ln1_g, ln1_b, ln2_g, ln2_b,
                     moe_router_group, moe_router_expert, moe_w_gate, moe_w_up, moe_w_down)
    return (y_prompt, y_sample)
```

```cpp
#include <hip/hip_runtime.h>
#include <hip/hip_cooperative_groups.h>
#include <cstdio>
#include <cstdint>
namespace cg = cooperative_groups;

#define LAS __attribute__((address_space(3)))
typedef unsigned short bf16_t;
typedef short bf16x8 __attribute__((ext_vector_type(8)));
typedef short s16x4 __attribute__((ext_vector_type(4)));
typedef float f32x4 __attribute__((ext_vector_type(4)));
typedef float f32x16 __attribute__((ext_vector_type(16)));
typedef unsigned u32x4 __attribute__((ext_vector_type(4)));
typedef unsigned u32x2 __attribute__((ext_vector_type(2)));
typedef _Float16 h16x8 __attribute__((ext_vector_type(8)));

constexpr int T = 49152, TP = 32768, DM = 1024;
constexpr int NG = 256;
constexpr int TPB = T / NG;
constexpr int MAXROWS = 2 * T + 16 * 256;
constexpr float LN_EPS = 1e-5f;
constexpr float ALPHA = 1.681792830507429f;
constexpr float C2 = 0.125f * 1.4426950408889634f;

constexpr size_t MiB = 1u << 20;
constexpr size_t WS_CNT = 0;
constexpr size_t WS_BAR = 65536;
constexpr size_t WS_ROPE = 1 * MiB;
constexpr size_t WS_TOK = 2 * MiB;
constexpr size_t WS_ROWI = 4 * MiB;
constexpr size_t WS_ROWW = 5 * MiB;
constexpr size_t WS_LSE = 6 * MiB;
constexpr size_t WS_W = 10 * MiB;
constexpr size_t W_DAIN = WS_W;
constexpr size_t W_DAOUT = W_DAIN + 12 * MiB;
constexpr size_t W_DLIN = W_DAOUT + 4 * MiB;
constexpr size_t W_DLOUT = W_DLIN + 36 * MiB;
constexpr size_t W_GU = W_DLOUT + 4 * MiB;
constexpr size_t W_DN = W_GU + 128 * MiB;
constexpr size_t WS_XB = W_DN + 64 * MiB;
constexpr size_t WS_BIG = WS_XB + 96 * MiB;
constexpr size_t BIG_H = WS_BIG + (size_t)MAXROWS * 2048;
constexpr size_t WS_END = WS_BIG + 300 * MiB;

constexpr int LDS_TAB = 131072;
constexpr int LDS_BYTES = 147456;

struct Params {
    const float* in[20];
    float* out;
    unsigned char* ws;
};

__device__ __forceinline__ unsigned cvt_pk_bf16(float lo, float hi) { unsigned r; asm("v_cvt_pk_bf16_f32 %0, %1, %2" : "=v"(r) : "v"(lo), "v"(hi)); return r; }
typedef _Float16 h16x2 __attribute__((ext_vector_type(2)));
typedef float f32x2_t __attribute__((ext_vector_type(2)));
__device__ __forceinline__ unsigned pk_h2(float lo, float hi) { const f32x2_t v = {lo, hi}; return __builtin_bit_cast(unsigned, __builtin_convertvector(v, h16x2)); }
__device__ __forceinline__ f32x2_t up_h2(unsigned w) { return __builtin_convertvector(__builtin_bit_cast(h16x2, w), f32x2_t); }
__device__ __forceinline__ float bf2f(unsigned short b) { return __uint_as_float(((unsigned)b) << 16); }
__device__ __forceinline__ float wave_sum(float v) {
#pragma unroll
    for (int o = 1; o < 64; o <<= 1) v += __shfl_xor(v, o);
    return v;
}
__device__ __forceinline__ float wave_allsum(float v) {
    v += __builtin_bit_cast(float, __builtin_amdgcn_update_dpp(0, __builtin_bit_cast(int, v), 0xB1, 0xF, 0xF, true));
    v += __builtin_bit_cast(float, __builtin_amdgcn_update_dpp(0, __builtin_bit_cast(int, v), 0x4E, 0xF, 0xF, true));
    v += __builtin_bit_cast(float, __builtin_amdgcn_update_dpp(0, __builtin_bit_cast(int, v), 0x141, 0xF, 0xF, true));
    v += __builtin_bit_cast(float, __builtin_amdgcn_update_dpp(0, __builtin_bit_cast(int, v), 0x140, 0xF, 0xF, true));
    const int vi = __builtin_bit_cast(int, v);
    return (__builtin_bit_cast(float, __builtin_amdgcn_readlane(vi, 0)) + __builtin_bit_cast(float, __builtin_amdgcn_readlane(vi, 16)))
         + (__builtin_bit_cast(float, __builtin_amdgcn_readlane(vi, 32)) + __builtin_bit_cast(float, __builtin_amdgcn_readlane(vi, 48)));
}
__device__ __forceinline__ int crow(int r, int hi) { return (r & 3) + 8 * (r >> 2) + 4 * hi; }
#define SBAR() __builtin_amdgcn_sched_barrier(0)
#define WAIT_BAR() asm volatile("s_waitcnt vmcnt(0) lgkmcnt(0)\n\ts_barrier" ::: "memory")
__device__ __forceinline__ void glds16(const void* gsrc, unsigned lds_dst) {
    unsigned keep;
    asm volatile("s_mov_b32 %0, m0\n\ts_mov_b32 m0, %2\n\ts_nop 0\n\tglobal_load_lds_dwordx4 %1, off\n\ts_mov_b32 m0, %0" : "=&s"(keep) : "v"(gsrc), "s"(lds_dst) : "memory");
}


#define XB_TMO      128
#define XB_XCNT(j)  (256  + 64 * (j))
#define XB_XSUB(j)  (1280 + 64 * (j))
#define XB_XGEN(j)  (2304 + 64 * (j))
#define XB_TOP      3328
#define XB_TOPGEN   3392
#define XCD_BAR_WORDS 3456
#define XB_SPIN_CAP (1u << 22)
__device__ __forceinline__ unsigned xb_ld(unsigned* p)              { return __hip_atomic_load(p, __ATOMIC_RELAXED, __HIP_MEMORY_SCOPE_AGENT); }
__device__ __forceinline__ unsigned xb_add(unsigned* p, unsigned v) { return __hip_atomic_fetch_add(p, v, __ATOMIC_RELAXED, __HIP_MEMORY_SCOPE_AGENT); }
__device__ __forceinline__ unsigned xb_xcc_id() { return (unsigned)__builtin_amdgcn_s_getreg((3 << 11) | 20) & 0xFu; }
#define XB_SPIN(cond, bar) do { unsigned _sp = 0; while (cond) { __builtin_amdgcn_s_sleep(1); \
    if ((++_sp & 255u) == 0u) { if (xb_ld(&(bar)[XB_TMO])) break; if (_sp > XB_SPIN_CAP) { atomicAdd(&(bar)[XB_TMO], 1u); break; } } } } while (0)
struct XcdBarrier { unsigned* bar; unsigned x; volatile LAS unsigned* st; };
__device__ __forceinline__ XcdBarrier xcd_barrier_post(unsigned* bar, volatile LAS unsigned* st) {
    XcdBarrier b; b.bar = bar; b.x = xb_xcc_id(); b.st = st;
    if (threadIdx.x == 0) (void)xb_add(&bar[XB_XCNT(b.x)], 1u);
    return b;
}
__device__ __forceinline__ void xcd_barrier_complete(unsigned* bar, unsigned x, unsigned& nloc, unsigned& nx) {
    const unsigned G = gridDim.x * gridDim.y * gridDim.z;
    unsigned sum, cnt, mine, sp = 0u;
    for (;;) {
        sum = 0u; cnt = 0u; mine = 0u;
#pragma unroll
        for (unsigned j = 0; j < 16; ++j) { const unsigned c = xb_ld(&bar[XB_XCNT(j)]); sum += c; cnt += (c > 0u) ? 1u : 0u; mine = (j == x) ? c : mine; }
        if (sum == G) break;
        __builtin_amdgcn_s_sleep(1);
        if ((++sp & 255u) == 0u) { if (xb_ld(&bar[XB_TMO])) break; if (sp > XB_SPIN_CAP) { atomicAdd(&bar[XB_TMO], 1u); break; } }
    }
    nloc = mine > 0u ? mine : 1u; nx = cnt > 0u ? cnt : 1u;
}
__device__ __forceinline__ void xcd_barrier(const XcdBarrier& b) {
    asm volatile("s_waitcnt vmcnt(0)" ::: "memory");
    __syncthreads();
    if (threadIdx.x == 0) {
        unsigned* bar = b.bar;
        __builtin_amdgcn_s_waitcnt(0);
        unsigned nloc = b.st[0], nx = b.st[1];
        if (nloc == 0u) { xcd_barrier_complete(bar, b.x, nloc, nx); b.st[0] = nloc; b.st[1] = nx; }
        const unsigned old = xb_add(&bar[XB_XSUB(b.x)], 1u);
        const unsigned gen = old / nloc;
        if (old + 1u == (gen + 1u) * nloc) {
            __builtin_amdgcn_fence(__ATOMIC_RELEASE, "agent");
            asm volatile("s_waitcnt vmcnt(0)" ::: "memory");
            const unsigned og = xb_add(&bar[XB_TOP], 1u);
            const unsigned tg = og / nx;
            if (og + 1u == (tg + 1u) * nx) xb_add(&bar[XB_TOPGEN], 1u);
            else XB_SPIN(xb_ld(&bar[XB_TOPGEN]) == tg, bar);
            __builtin_amdgcn_fence(__ATOMIC_ACQUIRE, "agent");
            xb_add(&bar[XB_XGEN(b.x)], 1u);
            asm volatile("s_waitcnt vmcnt(0)" ::: "memory");
        } else {
            XB_SPIN(xb_ld(&bar[XB_XGEN(b.x)]) == gen, bar);
            __builtin_amdgcn_fence(__ATOMIC_ACQUIRE, "agent");
            asm volatile("s_waitcnt vmcnt(0)" ::: "memory");
        }
    }
    __syncthreads();
}

namespace pg8 {
constexpr int BM = 256, BK = 64, HALF = 128, HTB = HALF * BK * 2, STAGE_BYTES = 8 * HTB;
__host__ __device__ __forceinline__ int lds_byte(int r, int c) { const int st = (r >> 4) * 2 + (c >> 5), rr = r & 15, cc = c & 31, ob = rr * 64 + cc * 2; return st * 1024 + (ob ^ (((ob >> 9) & 1) << 5)); }
__host__ __device__ __forceinline__ void stage_rc(int b, int& R, int& C) { const int st = b / 1024, sb = b % 1024, swz = sb ^ (((sb >> 9) & 1) << 5); R = (st >> 1) * 16 + swz / 64; C = (st & 1) * 32 + (swz % 64) / 2; }
__host__ __device__ __forceinline__ int perm32(int rho) { const int n = rho >> 4, i = rho & 15; return 8 * (i >> 2) + 4 * n + (i & 3); }

struct Unit { int pm, pn; const char* a; const char* b; };

template <bool F16, class Epi, class Sched>
__device__ __forceinline__ void gemm_phase(LAS unsigned char* lds, const int K, const int lda, const int ldb, const Sched& S, const Epi& E) {
    int tid = threadIdx.x; asm volatile("" : "+v"(tid));
    const int wid = __builtin_amdgcn_readfirstlane(tid >> 6), lane = tid & 63, wr = wid >> 2, wc = wid & 3, fr = lane & 15, fq = lane >> 4;
    const int nt = K / BK;
    unsigned voffA[2], voffB[2];
#pragma unroll
    for (int i = 0; i < 2; ++i) { int R, C; stage_rc(tid * 16 + i * 8192, R, C); const int Rb = (R & ~31) + perm32(R & 31);
        voffA[i] = (unsigned)(R * lda + C) * 2u; voffB[i] = (unsigned)(Rb * ldb + C) * 2u; }
    constexpr bool GA = Sched::GATHER;
    const size_t kstep = (size_t)(BK * 2);
    const size_t hstepA = GA ? (size_t)0 : (size_t)HALF * lda * 2, hstepB = (size_t)HALF * ldb * 2;
    unsigned go[2][2];
    go[0][0] = voffA[0]; go[0][1] = voffA[1]; go[1][0] = voffA[0]; go[1][1] = voffA[1];
#define PG8_GOLOAD(UI) do { int R0_, C0_; stage_rc(tid * 16, R0_, C0_); const LAS int* tb_ = S.tab + (UI) * 256; \
        go[0][0] = (unsigned)tb_[R0_] + (unsigned)(C0_ * 2); go[0][1] = (unsigned)tb_[R0_ + 64] + (unsigned)(C0_ * 2); \
        go[1][0] = (unsigned)tb_[128 + R0_] + (unsigned)(C0_ * 2); go[1][1] = (unsigned)tb_[128 + R0_ + 64] + (unsigned)(C0_ * 2); } while (0)
    const unsigned ldsw = (unsigned)wid * 1024u;
    const int aoff = lds_byte(wr * 64 + fr, fq * 8), boff = lds_byte(wc * 32 + fr, fq * 8);
#define PG8_SA(b, h) (((b) * 2 + (h)) * HTB)
#define PG8_SB(b, h) ((4 + (b) * 2 + (h)) * HTB)
#define PG8_STAGE(bufoff, gbase, voff) do { _Pragma("unroll") for (int _i = 0; _i < 2; ++_i) \
        __builtin_amdgcn_global_load_lds((const unsigned*)((const char*)(gbase) + (voff)[_i]), (LAS unsigned*)(lds + (bufoff) + ldsw + _i * 8192), 16, 0, 0); } while (0)
#define PG8_LDA(dst, b, h) do { _Pragma("unroll") for (int m = 0; m < 4; ++m) _Pragma("unroll") for (int k = 0; k < 2; ++k) dst[m][k] = *(const LAS bf16x8*)(lds + PG8_SA(b, h) + aoff + m * 2048 + k * 1024); } while (0)
#define PG8_LDB(dst, b, h) do { _Pragma("unroll") for (int n = 0; n < 2; ++n) _Pragma("unroll") for (int k = 0; k < 2; ++k) dst[n][k] = *(const LAS bf16x8*)(lds + PG8_SB(b, h) + boff + n * 2048 + k * 1024); } while (0)
#define PG8_MMA(ai, bj, At, Bt) do { __builtin_amdgcn_s_setprio(1); _Pragma("unroll") for (int m = 0; m < 4; ++m) _Pragma("unroll") for (int n = 0; n < 2; ++n) _Pragma("unroll") for (int k = 0; k < 2; ++k) \
        acc[ai][bj][m][n] = F16 ? __builtin_amdgcn_mfma_f32_16x16x32_f16(__builtin_bit_cast(h16x8, Bt[n][k]), __builtin_bit_cast(h16x8, At[m][k]), acc[ai][bj][m][n], 0, 0, 0) \
                                : __builtin_amdgcn_mfma_f32_16x16x32_bf16(Bt[n][k], At[m][k], acc[ai][bj][m][n], 0, 0, 0); __builtin_amdgcn_s_setprio(0); } while (0)
#define PG8_WAIT_V(n) asm volatile("s_waitcnt vmcnt(" #n ")" ::: "memory")
#define PG8_WAIT_L(n) asm volatile("s_waitcnt lgkmcnt(" #n ")" ::: "memory")
#define PG8_BAR __builtin_amdgcn_s_barrier()
#define PG8_SCHED __builtin_amdgcn_sched_barrier(0)
    Unit cur, nxt; int ui = 0;
    if constexpr (GA) {
        for (int e = tid; e < 8 * 256; e += 512) { Unit uu; if (S.next(e >> 8, uu)) { const int ri = S.rowinfo[uu.pm * BM + (e & 255)]; S.tab[e] = (ri < 0 ? 0 : (ri >> 1)) * (lda * 2); } }
        __syncthreads();
    }
    if (!S.next(0, cur)) return;
    if constexpr (GA) PG8_GOLOAD(0);
    f32x4 acc[2][2][4][2];
#pragma unroll
    for (int a = 0; a < 2; ++a)
#pragma unroll
        for (int b = 0; b < 2; ++b)
#pragma unroll
            for (int m = 0; m < 4; ++m)
#pragma unroll
                for (int n = 0; n < 2; ++n) acc[a][b][m][n] = (f32x4){0.f, 0.f, 0.f, 0.f};
    bf16x8 At[4][2], B0[2][2], B1[2][2];
    const char* cA = cur.a; const char* cB = cur.b;
    PG8_STAGE(PG8_SB(0, 0), cB, voffB); PG8_STAGE(PG8_SB(0, 1), cB + hstepB, voffB); PG8_STAGE(PG8_SA(0, 0), cA, go[0]); PG8_STAGE(PG8_SA(0, 1), cA + hstepA, go[1]);
    if (wr == 1) PG8_BAR;
    PG8_WAIT_V(2); PG8_BAR;
    PG8_STAGE(PG8_SB(1, 0), cB + kstep, voffB); PG8_STAGE(PG8_SA(1, 0), cA + kstep, go[0]); PG8_STAGE(PG8_SB(1, 1), cB + hstepB + kstep, voffB);
    PG8_WAIT_V(6); PG8_BAR;
    for (;;) {
        const bool has_next = S.next(ui + 1, nxt);
        const char* nA = has_next ? nxt.a : cA; const char* nB = has_next ? nxt.b : cB;
        for (int t = 0; t < nt; t += 2) {
            const bool last = (t == nt - 2);
            const char* a1 = cA + (size_t)(t + 1) * kstep;
            const char* a2 = last ? nA : cA + (size_t)(t + 2) * kstep; const char* b2 = last ? nB : cB + (size_t)(t + 2) * kstep;
            const char* a3 = a2 + kstep; const char* b3 = b2 + kstep;
            PG8_LDB(B0, 0, 0); PG8_LDB(B1, 0, 1); PG8_SCHED; PG8_LDA(At, 0, 0); PG8_STAGE(PG8_SA(1, 1), a1 + hstepA, go[1]);
            if constexpr (GA) { if (last && has_next) PG8_GOLOAD(ui + 1); }
            PG8_WAIT_V(8); PG8_WAIT_L(0); PG8_BAR; PG8_MMA(0, 0, At, B0); PG8_MMA(0, 1, At, B1); PG8_BAR; PG8_SCHED;
            PG8_LDA(At, 0, 1); PG8_STAGE(PG8_SB(0, 0), b2, voffB); PG8_STAGE(PG8_SB(0, 1), b2 + hstepB, voffB); PG8_STAGE(PG8_SA(0, 0), a2, go[0]);
            PG8_WAIT_V(8); PG8_WAIT_L(0); PG8_BAR; PG8_MMA(1, 0, At, B0); PG8_MMA(1, 1, At, B1); PG8_BAR; PG8_SCHED;
            PG8_LDB(B0, 1, 0); PG8_LDB(B1, 1, 1); PG8_SCHED; PG8_LDA(At, 1, 0); PG8_STAGE(PG8_SA(0, 1), a2 + hstepA, go[1]);
            PG8_WAIT_V(8); PG8_WAIT_L(0); PG8_BAR; PG8_MMA(0, 0, At, B0); PG8_MMA(0, 1, At, B1); PG8_BAR; PG8_SCHED;
            PG8_LDA(At, 1, 1); PG8_STAGE(PG8_SB(1, 0), b3, voffB); PG8_STAGE(PG8_SB(1, 1), b3 + hstepB, voffB); PG8_STAGE(PG8_SA(1, 0), a3, go[0]);
            PG8_WAIT_V(8); PG8_WAIT_L(0); PG8_BAR; PG8_MMA(1, 0, At, B0); PG8_MMA(1, 1, At, B1); PG8_BAR; PG8_SCHED;
        }
        if (wr == 0) PG8_BAR;
        E(acc, cur, wr, wc, fr, fq);
        if (!has_next) break;
#pragma unroll
        for (int a = 0; a < 2; ++a)
#pragma unroll
            for (int b = 0; b < 2; ++b)
#pragma unroll
                for (int m = 0; m < 4; ++m)
#pragma unroll
                    for (int n = 0; n < 2; ++n) acc[a][b][m][n] = (f32x4){0.f, 0.f, 0.f, 0.f};
        cur = nxt; cA = nA; cB = nB; ++ui;
        if (wr == 1) PG8_BAR;
    }
    PG8_WAIT_V(0);
    PG8_BAR;
#undef PG8_SA
#undef PG8_SB
#undef PG8_STAGE
#undef PG8_GOLOAD
#undef PG8_LDA
#undef PG8_LDB
#undef PG8_MMA
#undef PG8_WAIT_V
#undef PG8_WAIT_L
#undef PG8_BAR
#undef PG8_SCHED
}

struct SchedDense {
    static constexpr bool GATHER = false; LAS int* tab; const int* rowinfo;
    int nM, nN, nwg, G, c; const char* A; const char* B; size_t ta, tb;
    __device__ void init(int M, int N, int G_, int c_, const void* A_, int lda, const void* B_, int ldb) {
        nM = M / BM; nN = N / BM; nwg = nM * nN; G = G_; c = c_; A = (const char*)A_; B = (const char*)B_; ta = (size_t)BM * lda * 2; tb = (size_t)BM * ldb * 2; }
    __device__ bool next(int i, Unit& u) const {
        const long L = (long)i * G + c; if (L >= nwg) return false;
        int wgid = (int)L; { const int q = nwg / 8, r = nwg % 8, xcd = wgid % 8, off = wgid / 8; wgid = (xcd < r ? xcd * (q + 1) : r * (q + 1) + (xcd - r) * q) + off; }
        const int nig = 8 * nN, gid = wgid / nig, fm = gid * 8, gsz = (nM - fm) < 8 ? (nM - fm) : 8;
        u.pm = fm + ((wgid % nig) % gsz); u.pn = (wgid % nig) / gsz;
        u.a = A + (size_t)u.pm * ta; u.b = B + (size_t)u.pn * tb; return true;
    }
};
template <bool GATHER_>
struct SchedMoE {
    static constexpr bool GATHER = GATHER_; LAS int* tab; const int* rowinfo;
    const LAS int* off; int G, c; const char* A; const char* B; size_t ta, tb, eb;
    __device__ bool next(int i, Unit& u) const {
        const int ntile = off[16] >> 8; const int v = i * (G >> 3) + (c >> 3); const int m = (v >> 2) * 8 + (c & 7), pn = v & 3;
        if (m >= ntile) return false;
        const int row = m << 8; int b = 0;
#pragma unroll
        for (int k = 1; k < 16; ++k) b += (row >= off[k]) ? 1 : 0;
        u.pm = m; u.pn = pn; u.a = A + (size_t)m * ta; u.b = B + (size_t)b * eb + (size_t)pn * tb; return true;
    }
};

struct EpiProj {
    bf16_t* O; int ldc; const float* rope; int rowbase;
    __device__ __forceinline__ void operator()(const f32x4 (&acc)[2][2][4][2], const Unit& u, int wr, int wc, int fr, int fq) const {
        const int typ = ((u.pn * BM) % 3072) >> 10;
        const float sc = (typ == 0) ? C2 : 1.f;
        const bool dorope = (typ < 2) && ((wc & 1) == 0);
        const int row0 = u.pm * BM + wr * 64 + fr, col0 = u.pn * BM + wc * 32 + 8 * fq;
#pragma unroll
        for (int ai = 0; ai < 2; ++ai)
#pragma unroll
            for (int m = 0; m < 4; ++m) {
                const int row = row0 + ai * HALF + m * 16;
                f32x4 t0 = {1.f, 0.f, 1.f, 0.f}, t1 = t0;
                if (dorope && fq < 2) { const int tok = rowbase + row; const int pos = tok < TP ? (tok & 8191) : (tok & 4095);
                    const f32x4* tp = (const f32x4*)(rope + (size_t)pos * 16 + 8 * fq); t0 = tp[0]; t1 = tp[1]; }
                bf16_t* rowp = O + (size_t)row * ldc + col0;
#pragma unroll
                for (int bj = 0; bj < 2; ++bj) {
                    f32x4 v0 = acc[ai][bj][m][0], v1 = acc[ai][bj][m][1];
                    if (dorope && fq < 2) {
                        const f32x4 a = v0, b = v1;
                        v0[0] = a[0] * t0[0] - b[0] * t0[1]; v1[0] = b[0] * t0[0] + a[0] * t0[1];
                        v0[1] = a[1] * t0[2] - b[1] * t0[3]; v1[1] = b[1] * t0[2] + a[1] * t0[3];
                        v0[2] = a[2] * t1[0] - b[2] * t1[1]; v1[2] = b[2] * t1[0] + a[2] * t1[1];
                        v0[3] = a[3] * t1[2] - b[3] * t1[3]; v1[3] = b[3] * t1[2] + a[3] * t1[3];
                    }
                    v0 = v0 * sc; v1 = v1 * sc;
                    u32x4 w; w.x = cvt_pk_bf16(v0[0], v0[1]); w.y = cvt_pk_bf16(v0[2], v0[3]); w.z = cvt_pk_bf16(v1[0], v1[1]); w.w = cvt_pk_bf16(v1[2], v1[3]);
                    *(u32x4*)(rowp + bj * HALF) = w;
                }
            }
    }
};
struct EpiRes {
    const unsigned short* XH; unsigned short* Z; int rowbase;
    __device__ __forceinline__ void operator()(const f32x4 (&acc)[2][2][4][2], const Unit& u, int wr, int wc, int fr, int fq) const {
        const int row0 = rowbase + u.pm * BM + wr * 64 + fr, col0 = u.pn * BM + wc * 32 + 8 * fq;
#pragma unroll
        for (int ai = 0; ai < 2; ++ai)
#pragma unroll
            for (int m = 0; m < 4; ++m) {
                const size_t ro = (size_t)(row0 + ai * HALF + m * 16) * DM;
#pragma unroll
                for (int bj = 0; bj < 2; ++bj) { const int col = col0 + bj * HALF;
                    const u32x4 xh = *(const u32x4*)(XH + ro + col);
                    const f32x4 a0 = acc[ai][bj][m][0], a1 = acc[ai][bj][m][1];
                    const f32x2_t x0 = up_h2(xh.x), x1 = up_h2(xh.y), x2 = up_h2(xh.z), x3 = up_h2(xh.w);
                    u32x4 w;
                    w.x = pk_h2(x0[0] * ALPHA + a0[0], x0[1] * ALPHA + a0[1]);
                    w.y = pk_h2(x1[0] * ALPHA + a0[2], x1[1] * ALPHA + a0[3]);
                    w.z = pk_h2(x2[0] * ALPHA + a1[0], x2[1] * ALPHA + a1[1]);
                    w.w = pk_h2(x3[0] * ALPHA + a1[2], x3[1] * ALPHA + a1[3]);
                    *(u32x4*)(Z + ro + col) = w; }
            }
    }
};
struct EpiGU {
    bf16_t* H; const float* roww;
    __device__ __forceinline__ void operator()(const f32x4 (&acc)[2][2][4][2], const Unit& u, int wr, int wc, int fr, int fq) const {
        const int row0 = u.pm * BM + wr * 64 + fr, col0 = u.pn * HALF + wc * 32 + 8 * fq;
#pragma unroll
        for (int ai = 0; ai < 2; ++ai)
#pragma unroll
            for (int m = 0; m < 4; ++m) {
                const int row = row0 + ai * HALF + m * 16; const float w = roww[row];
                unsigned pk[4];
#pragma unroll
                for (int n = 0; n < 2; ++n) { const f32x4 g = acc[ai][0][m][n], up = acc[ai][1][m][n]; float h[4];
#pragma unroll
                    for (int e = 0; e < 4; ++e) { const float s = __builtin_amdgcn_rcpf(1.f + __builtin_amdgcn_exp2f(-1.4426950408889634f * g[e])); h[e] = g[e] * s * up[e] * w; }
                    pk[2 * n] = cvt_pk_bf16(h[0], h[1]); pk[2 * n + 1] = cvt_pk_bf16(h[2], h[3]); }
                *(u32x4*)(H + (size_t)row * 512 + col0) = (u32x4){pk[0], pk[1], pk[2], pk[3]};
            }
    }
};
struct EpiDown {
    bf16_t* Y; const int* rowinfo;
    __device__ __forceinline__ void operator()(const f32x4 (&acc)[2][2][4][2], const Unit& u, int wr, int wc, int fr, int fq) const {
        const int row0 = u.pm * BM + wr * 64 + fr, col0 = u.pn * BM + wc * 32 + 8 * fq;
#pragma unroll
        for (int ai = 0; ai < 2; ++ai)
#pragma unroll
            for (int m = 0; m < 4; ++m) {
                const int row = row0 + ai * HALF + m * 16; const int d = rowinfo[row];
                if (d >= 0) {
#pragma unroll
                    for (int bj = 0; bj < 2; ++bj) { const f32x4 v0 = acc[ai][bj][m][0], v1 = acc[ai][bj][m][1];
                        u32x4 w; w.x = cvt_pk_bf16(v0[0], v0[1]); w.y = cvt_pk_bf16(v0[2], v0[3]); w.z = cvt_pk_bf16(v1[0], v1[1]); w.w = cvt_pk_bf16(v1[2], v1[3]);
                        *(u32x4*)(Y + (size_t)d * DM + col0 + bj * HALF) = w; }
                }
            }
    }
};
}

template <bool F16>
__device__ __forceinline__ void cvt_item(const float* W, int ldw, int col0, int k0, bf16_t* WT, int K, int n0, LAS float* scr, int lane, bool rperm = false) {
    const int c_ = lane & 31; const int sc_ = (rperm && c_ < 16 && ((c_ >> 2) == 1 || (c_ >> 2) == 2)) ? (c_ ^ 12) : c_;
#pragma unroll 8
    for (int i = 0; i < 32; ++i) { const int kk = 2 * i + (lane >> 5); scr[kk * 33 + c_] = W[(size_t)(k0 + kk) * ldw + col0 + sc_]; }
    asm volatile("s_waitcnt lgkmcnt(0)" ::: "memory");
    const int c = lane & 7;
#pragma unroll
    for (int j = 0; j < 4; ++j) { const int n = (lane >> 3) + 8 * j; const LAS float* s = scr + (8 * c) * 33 + n;
        u32x4 o;
        if (F16) { o.x = pk_h2(s[0 * 33], s[1 * 33]); o.y = pk_h2(s[2 * 33], s[3 * 33]); o.z = pk_h2(s[4 * 33], s[5 * 33]); o.w = pk_h2(s[6 * 33], s[7 * 33]); }
        else { o.x = cvt_pk_bf16(s[0 * 33], s[1 * 33]); o.y = cvt_pk_bf16(s[2 * 33], s[3 * 33]); o.z = cvt_pk_bf16(s[4 * 33], s[5 * 33]); o.w = cvt_pk_bf16(s[6 * 33], s[7 * 33]); }
        *(u32x4*)(WT + (size_t)(n0 + n) * K + k0 + 8 * c) = o; }
    asm volatile("s_waitcnt lgkmcnt(0)" ::: "memory");
}

__device__ __forceinline__ void prologue(const Params& P, LAS unsigned char* lds) {
    int tid = threadIdx.x; asm volatile("" : "+v"(tid)); const int wid = __builtin_amdgcn_readfirstlane(tid >> 6), lane = tid & 63;
    unsigned char* ws = P.ws;
    LAS float* scr = (LAS float*)(lds + wid * 16384);
    const int gw = blockIdx.x * 8 + wid, NGW = NG * 8;
    constexpr int N_A = 3072, N_B = 1024, N_C = 9216, N_D = 1024, N_E = 32768, N_F = 16384;
    for (int it = gw; it < N_A + N_B + N_C + N_D + N_E + N_F; it += NGW) {
        int gi = it;
        if (gi < N_A) { const int mat = gi / 1536, r = gi % 1536, kb = r / 96, nb = r % 96, n0 = 32 * nb; int col0 = n0;
            if (n0 < 2048) { const int base = (n0 >= 1024) ? 1024 : 0, nn = n0 & 1023, hh = nn >> 7, w = nn & 127; col0 = base + (w < 64 ? hh * 64 + w : 512 + hh * 64 + (w - 64)); }
            cvt_item<true>(P.in[2] + (size_t)mat * 1024 * 3072, 3072, col0, 64 * kb, (bf16_t*)(ws + W_DAIN) + (size_t)mat * 3072 * 1024, 1024, n0, scr, lane, n0 < 2048 && (n0 & 63) == 0); continue; }
        gi -= N_A;
        if (gi < N_B) { const int mat = gi / 512, r = gi % 512, kb = r / 32, nb = r % 32;
            cvt_item<false>(P.in[3] + (size_t)mat * 1024 * 1024, 1024, 32 * nb, 64 * kb, (bf16_t*)(ws + W_DAOUT) + (size_t)mat * 1024 * 1024, 1024, 32 * nb, scr, lane); continue; }
        gi -= N_B;
        if (gi < N_C) { const int mat = gi / 4608, r = gi % 4608, kb = r / 288, nb = r % 288;
            cvt_item<true>(P.in[9] + (size_t)mat * 1024 * 9216, 9216, 32 * nb, 64 * kb, (bf16_t*)(ws + W_DLIN) + (size_t)mat * 9216 * 1024, 1024, 32 * nb, scr, lane, ((32 * nb) % 3072) < 2048 && ((32 * nb) & 63) == 0); continue; }
        gi -= N_C;
        if (gi < N_D) { const int mat = gi / 512, r = gi % 512, kb = r / 32, nb = r % 32;
            cvt_item<false>(P.in[10] + (size_t)mat * 1024 * 1024, 1024, 32 * nb, 64 * kb, (bf16_t*)(ws + W_DLOUT) + (size_t)mat * 1024 * 1024, 1024, 32 * nb, scr, lane); continue; }
        gi -= N_D;
        if (gi < N_E) { const int mat = gi / 512, r = gi % 512, kb = r / 32, nb = r % 32, n0 = 32 * nb, pn = n0 >> 8, w = n0 & 255;
            const float* src = ((w < 128) ? P.in[17] : P.in[18]) + (size_t)mat * 1024 * 512;
            cvt_item<true>(src, 512, pn * 128 + (w & 127), 64 * kb, (bf16_t*)(ws + W_GU) + (size_t)mat * 1024 * 1024, 1024, n0, scr, lane); continue; }
        gi -= N_E;
        { const int mat = gi / 256, r = gi % 256, kb = r / 32, nb = r % 32;
            cvt_item<false>(P.in[19] + (size_t)mat * 512 * 1024, 1024, 32 * nb, 64 * kb, (bf16_t*)(ws + W_DN) + (size_t)mat * 1024 * 512, 512, 32 * nb, scr, lane); }
    }
    for (int i = blockIdx.x * 512 + tid; i < 8192 * 8; i += NG * 512) {
        const int pos = i >> 3, j = i & 7;
        const float inv = (float)exp(-(double)j * 0.125 * 13.122363377404328);
        const float ang = (float)pos * inv;
        const double rev = (double)ang * 0.15915494309189535; const float fr = (float)(rev - rint(rev));
        float* tp = (float*)(ws + WS_ROPE) + (size_t)i * 2;
        tp[0] = __builtin_amdgcn_cosf(fr); tp[1] = __builtin_amdgcn_sinf(fr);
    }
    unsigned short* XH0 = (unsigned short*)P.out + (size_t)T * DM;
    for (size_t i = (size_t)blockIdx.x * 512 + tid; i < (size_t)T * DM / 8; i += (size_t)NG * 512) {
        const size_t e = i * 8; const float* src = (e < (size_t)TP * DM) ? P.in[0] + e : P.in[1] + (e - (size_t)TP * DM);
        const f32x4 a = *(const f32x4*)src, b = *(const f32x4*)(src + 4);
        *(u32x4*)(XH0 + e) = (u32x4){pk_h2(a[0], a[1]), pk_h2(a[2], a[3]), pk_h2(b[0], b[1]), pk_h2(b[2], b[3])};
    }
}

template <int NTK>
__device__ __forceinline__ void ln_rows(f32x4 (&v)[NTK][4], const float* g, const float* b, float* Xout, unsigned short* XH, const int (&tok)[NTK], int lane) {
    float s[NTK], s2[NTK];
#pragma unroll
    for (int t = 0; t < NTK; ++t) { s[t] = 0.f;
#pragma unroll
        for (int j = 0; j < 4; ++j) s[t] += (v[t][j][0] + v[t][j][1]) + (v[t][j][2] + v[t][j][3]); }
#pragma unroll
    for (int t = 0; t < NTK; ++t) s[t] = wave_allsum(s[t]);
#pragma unroll
    for (int t = 0; t < NTK; ++t) { const float mean = s[t] * (1.f / DM); s2[t] = 0.f;
#pragma unroll
        for (int j = 0; j < 4; ++j) { v[t][j] = v[t][j] - mean; s2[t] += (v[t][j][0] * v[t][j][0] + v[t][j][1] * v[t][j][1]) + (v[t][j][2] * v[t][j][2] + v[t][j][3] * v[t][j][3]); } }
#pragma unroll
    for (int t = 0; t < NTK; ++t) s2[t] = wave_allsum(s2[t]);
#pragma unroll
    for (int j = 0; j < 4; ++j) { const f32x4 gg = *(const f32x4*)(g + 256 * j + 4 * lane), bb = *(const f32x4*)(b + 256 * j + 4 * lane);
#pragma unroll
        for (int t = 0; t < NTK; ++t) { const float rstd = 1.0f / sqrtf(s2[t] * (1.f / DM) + LN_EPS);
            v[t][j] = v[t][j] * rstd * gg + bb;
            if (Xout) *(f32x4*)(Xout + (size_t)tok[t] * DM + 256 * j + 4 * lane) = v[t][j];
            else *(u32x2*)(XH + (size_t)tok[t] * DM + 256 * j + 4 * lane) = (u32x2){pk_h2(v[t][j][0], v[t][j][1]), pk_h2(v[t][j][2], v[t][j][3])}; } }
}

__device__ __forceinline__ void phase_ln1_router(const Params& P, int layer, LAS unsigned char* lds) {
    constexpr int NTK = 2;
    int tid = threadIdx.x; asm volatile("" : "+v"(tid)); const int wid = __builtin_amdgcn_readfirstlane(tid >> 6), lane_ = tid & 63;
    unsigned char* ws = P.ws; const unsigned short* Z = (const unsigned short*)P.out; unsigned short* XH = (layer == 3) ? (unsigned short*)(ws + WS_XB) : (unsigned short*)P.out + (size_t)T * DM;
    LAS int* lcnt = (LAS int*)(lds + LDS_TAB + 512);
    if (tid < 16) lcnt[tid] = 0;
    const float* g = P.in[11] + layer * DM; const float* b = P.in[12] + layer * DM;
    const float* Wg = P.in[15] + (size_t)layer * DM * 4; const float* We = P.in[16] + (size_t)layer * DM * 16;
    LAS f32x4* W2 = (LAS f32x4*)lds;
    for (int item = tid; item < 5 * 1024; item += 512) { const int plane = item >> 10, k = item & 1023;
        const f32x4 w = (plane == 0) ? *(const f32x4*)(Wg + 4 * k) : *(const f32x4*)(We + 16 * k + 4 * (plane - 1));
        W2[(((k >> 8) * 4 + (k & 3)) * 5 + plane) * 64 + ((k & 255) >> 2)] = w; }
    __syncthreads();
    int* tokinfo = (int*)(ws + WS_TOK);
    for (int it = 0; it < TPB / 8; it += NTK) {
        int lane = lane_; asm volatile("" : "+v"(lane));
        int tok[NTK]; f32x4 v[NTK][4];
#pragma unroll
        for (int t = 0; t < NTK; ++t) { tok[t] = blockIdx.x * TPB + (it + t) * 8 + wid;
#pragma unroll
            for (int j = 0; j < 4; ++j) { const u32x2 z = *(const u32x2*)(Z + (size_t)tok[t] * DM + 256 * j + 4 * lane);
                const f32x2_t z0 = up_h2(z.x), z1 = up_h2(z.y); v[t][j] = (f32x4){z0[0], z0[1], z1[0], z1[1]}; } }
        ln_rows<NTK>(v, g, b, nullptr, XH, tok, lane);
        float lg[NTK][4];
#pragma unroll
        for (int t = 0; t < NTK; ++t) { lg[t][0] = 0.f; lg[t][1] = 0.f; lg[t][2] = 0.f; lg[t][3] = 0.f; }
#pragma unroll
        for (int j = 0; j < 4; ++j)
#pragma unroll
            for (int e = 0; e < 4; ++e) { const f32x4 w = W2[((j * 4 + e) * 5) * 64 + lane];
#pragma unroll
                for (int t = 0; t < NTK; ++t) { lg[t][0] += v[t][j][e] * w[0]; lg[t][1] += v[t][j][e] * w[1]; lg[t][2] += v[t][j][e] * w[2]; lg[t][3] += v[t][j][e] * w[3]; } }
#pragma unroll
        for (int t = 0; t < NTK; ++t)
#pragma unroll
            for (int q = 0; q < 4; ++q) lg[t][q] = wave_allsum(lg[t][q]);
        int gs[NTK]; float gw[NTK]; float el[NTK][4];
#pragma unroll
        for (int t = 0; t < NTK; ++t) { int gsel = 0; float gm = lg[t][0];
#pragma unroll
            for (int q = 1; q < 4; ++q) if (lg[t][q] > gm) { gm = lg[t][q]; gsel = q; }
            float den = 0.f;
#pragma unroll
            for (int q = 0; q < 4; ++q) den += __expf(lg[t][q] - gm);
            gw[t] = 1.f / den; gs[t] = __builtin_amdgcn_readfirstlane(gsel);
            el[t][0] = 0.f; el[t][1] = 0.f; el[t][2] = 0.f; el[t][3] = 0.f; }
#pragma unroll
        for (int j = 0; j < 4; ++j)
#pragma unroll
            for (int e = 0; e < 4; ++e) { const LAS f32x4* wr_ = W2 + ((j * 4 + e) * 5 + 1) * 64 + lane;
#pragma unroll
                for (int t = 0; t < NTK; ++t) { const f32x4 w = wr_[gs[t] * 64];
                    el[t][0] += v[t][j][e] * w[0]; el[t][1] += v[t][j][e] * w[1]; el[t][2] += v[t][j][e] * w[2]; el[t][3] += v[t][j][e] * w[3]; } }
#pragma unroll
        for (int t = 0; t < NTK; ++t)
#pragma unroll
            for (int q = 0; q < 4; ++q) el[t][q] = wave_allsum(el[t][q]);
#pragma unroll
        for (int t = 0; t < NTK; ++t) {
            int i1 = 0; float v1 = el[t][0];
#pragma unroll
            for (int q = 1; q < 4; ++q) if (el[t][q] > v1) { v1 = el[t][q]; i1 = q; }
            int i2 = -1; float v2 = -3.0e38f;
#pragma unroll
            for (int q = 0; q < 4; ++q) if (q != i1 && el[t][q] > v2) { v2 = el[t][q]; i2 = q; }
            const float w1 = gw[t] / (1.f + __expf(v2 - v1)); const float w2 = gw[t] - w1;
            if (lane == 0) {
                const int b1 = gs[t] * 4 + i1, b2 = gs[t] * 4 + i2;
                const int s1 = atomicAdd((int*)(lcnt + b1), 1); const int s2 = atomicAdd((int*)(lcnt + b2), 1);
                int* ti = tokinfo + (size_t)tok[t] * 8;
                ti[0] = b1; ti[1] = s1; ti[2] = __float_as_int(w1); ti[3] = b2; ti[4] = s2; ti[5] = __float_as_int(w2);
            }
        }
    }
    __syncthreads();
    if (tid < 16) ((int*)(ws + WS_CNT))[blockIdx.x * 16 + tid] = lcnt[tid];
}

__device__ __forceinline__ void phase_gather(const Params& P, int layer, LAS unsigned char* lds) {
    constexpr int NTK = 4;
    int tid = threadIdx.x; asm volatile("" : "+v"(tid)); const int wid = __builtin_amdgcn_readfirstlane(tid >> 6), lane_ = tid & 63;
    unsigned char* ws = P.ws;
    LAS int* off = (LAS int*)(lds + LDS_TAB);
    LAS int* lbase = (LAS int*)(lds + LDS_TAB + 128);
    LAS int* ltot = (LAS int*)(lds + LDS_TAB + 256);
    const int* cnt = (const int*)(ws + WS_CNT);
    int* rowinfo = (int*)(ws + WS_ROWI); float* roww = (float*)(ws + WS_ROWW);
    if (tid < 256) { const int b = tid & 15, part = tid >> 4; int tot = 0, mine = 0;
        for (int k = 0; k < 16; ++k) { const int blk = part * 16 + k; const int c = cnt[blk * 16 + b]; mine += (blk < (int)blockIdx.x) ? c : 0; tot += c; }
        LAS int* pt = (LAS int*)(lds + 0); pt[tid] = tot; pt[256 + tid] = mine; }
    __syncthreads();
    if (tid < 16) { const LAS int* pt = (const LAS int*)(lds + 0); int tot = 0, mine = 0;
        for (int k = 0; k < 16; ++k) { tot += pt[k * 16 + tid]; mine += pt[256 + k * 16 + tid]; }
        ltot[tid] = tot; lbase[tid] = mine; }
    __syncthreads();
    if (tid == 0) { int o = 0; for (int b = 0; b < 16; ++b) { off[b] = o; o += (ltot[b] + 255) & ~255; } off[16] = o; }
    __syncthreads();
    if (blockIdx.x < 16) { const int b = blockIdx.x; for (int r = off[b] + ltot[b] + tid; r < off[b + 1]; r += 512) { rowinfo[r] = -1; roww[r] = 0.f; } }
    const int* tokinfo = (const int*)(ws + WS_TOK);
    for (int it = 0; it < TPB / 8; it += NTK) {
        int lane = lane_; asm volatile("" : "+v"(lane));
        int tok[NTK], r1[NTK], r2[NTK]; int w1[NTK], w2[NTK];
#pragma unroll
        for (int t = 0; t < NTK; ++t) { tok[t] = blockIdx.x * TPB + (it + t) * 8 + wid;
            const int* ti = tokinfo + (size_t)tok[t] * 8;
            const int b1 = ti[0], s1 = ti[1], b2 = ti[3], s2 = ti[4]; w1[t] = ti[2]; w2[t] = ti[5];
            r1[t] = off[b1] + lbase[b1] + s1; r2[t] = off[b2] + lbase[b2] + s2; }
#pragma unroll
        for (int t = 0; t < NTK; ++t) {
            if (lane == 0) { rowinfo[r1[t]] = tok[t] * 2; roww[r1[t]] = __int_as_float(w1[t]); rowinfo[r2[t]] = tok[t] * 2 + 1; roww[r2[t]] = __int_as_float(w2[t]); } }
    }
}

__device__ __forceinline__ void phase_ln2(const Params& P, int layer) {
    constexpr int NTK = 4;
    int tid = threadIdx.x; asm volatile("" : "+v"(tid)); const int wid = __builtin_amdgcn_readfirstlane(tid >> 6), lane_ = tid & 63;
    unsigned char* ws = P.ws; float* Xout = (layer == 3) ? P.out : nullptr; unsigned short* XH = (layer == 3) ? (unsigned short*)(ws + WS_XB) : (unsigned short*)P.out + (size_t)T * DM; const bf16_t* Y = (const bf16_t*)(ws + WS_BIG);
    const float* g = P.in[13] + layer * DM; const float* b = P.in[14] + layer * DM;
    for (int it = 0; it < TPB / 8; it += NTK) {
        int lane = lane_; asm volatile("" : "+v"(lane));
        int tok[NTK]; f32x4 v[NTK][4];
#pragma unroll
        for (int t = 0; t < NTK; ++t) { tok[t] = blockIdx.x * TPB + (it + t) * 8 + wid;
#pragma unroll
            for (int j = 0; j < 4; ++j) { f32x4 x;
                { const u32x2 xh = *(const u32x2*)(XH + (size_t)tok[t] * DM + 256 * j + 4 * lane); const f32x2_t h0 = up_h2(xh.x), h1 = up_h2(xh.y); x = (f32x4){h0[0], h0[1], h1[0], h1[1]}; }
                const u32x2 y0 = *(const u32x2*)(Y + (size_t)(2 * tok[t]) * DM + 256 * j + 4 * lane), y1 = *(const u32x2*)(Y + (size_t)(2 * tok[t] + 1) * DM + 256 * j + 4 * lane);
                f32x4 f0 = {__uint_as_float(y0.x << 16), __uint_as_float(y0.x & 0xffff0000u), __uint_as_float(y0.y << 16), __uint_as_float(y0.y & 0xffff0000u)};
                f32x4 f1 = {__uint_as_float(y1.x << 16), __uint_as_float(y1.x & 0xffff0000u), __uint_as_float(y1.y << 16), __uint_as_float(y1.y & 0xffff0000u)};
                v[t][j] = x * ALPHA + f0 + f1; } }
        ln_rows<NTK>(v, g, b, Xout, XH, tok, lane);
    }
}

#define KSWZ(row, colB) ((row) * 256 + ((colB) ^ (((row) & 15) << 4)))
__device__ __forceinline__ int v_rd_base(int lane) { return ((lane & 3) << 3) | (((lane >> 2) & 3) << 6) | (((lane >> 4) & 1) << 5) | (((lane >> 5) & 1) << 8); }
#define TR_READ(dst, vb, OFF) asm volatile("ds_read_b64_tr_b16 %0, %1 offset:%c2" : "=&v"(dst) : "v"(vb), "i"(OFF) : "memory")
#define PKV(L, H) (bf16x8){L[0], L[1], L[2], L[3], H[0], H[1], H[2], H[3]}
#define PK4(P, BASE, OUT) do { u32x4 w_ = {cvt_pk_bf16(P[BASE + 0], P[BASE + 1]), cvt_pk_bf16(P[BASE + 2], P[BASE + 3]), \
    cvt_pk_bf16(P[BASE + 4], P[BASE + 5]), cvt_pk_bf16(P[BASE + 6], P[BASE + 7])}; OUT = __builtin_bit_cast(bf16x8, w_); } while (0)
constexpr float THR2 = 11.5f;

__device__ __forceinline__ void softmax_tile(f32x16& p0, f32x16& p1, float& m_reg, float& l_reg, float& alpha, bf16x8& a0, bf16x8& a1, bf16x8& a2, bf16x8& a3) {
    float pmax = p0[0];
#pragma unroll
    for (int r = 1; r < 16; ++r) pmax = fmaxf(pmax, p0[r]);
#pragma unroll
    for (int r = 0; r < 16; ++r) pmax = fmaxf(pmax, p1[r]);
    { auto rr = __builtin_amdgcn_permlane32_swap(__float_as_uint(pmax), __float_as_uint(pmax), false, false); pmax = fmaxf(__uint_as_float(rr[0]), __uint_as_float(rr[1])); }
    if (__builtin_expect(__all(pmax - m_reg <= THR2), 1)) { alpha = 1.f; }
    else { const float mn = fmaxf(m_reg, pmax); alpha = __builtin_amdgcn_exp2f(m_reg - mn); m_reg = mn; }
#pragma unroll
    for (int r = 0; r < 16; ++r) { p0[r] = __builtin_amdgcn_exp2f(p0[r] - m_reg); p1[r] = __builtin_amdgcn_exp2f(p1[r] - m_reg); }
    float ps = 0.f;
#pragma unroll
    for (int r = 0; r < 16; ++r) ps += p0[r] + p1[r];
    { auto rr = __builtin_amdgcn_permlane32_swap(__float_as_uint(ps), __float_as_uint(ps), false, false); ps = __uint_as_float(rr[0]) + __uint_as_float(rr[1]); }
    l_reg = l_reg * alpha + ps;
    PK4(p0, 0, a0); PK4(p0, 8, a1); PK4(p1, 0, a2); PK4(p1, 8, a3);
}

typedef float f32x2 __attribute__((ext_vector_type(2)));
template <bool FIRST>
__device__ __forceinline__ void partialSM(f32x16& p0, f32x16& p1, float& mhat, f32x16& negm, float& alpha) {
    float pmax = p0[0];
#pragma unroll
    for (int r = 1; r < 16; ++r) pmax = fmaxf(pmax, p0[r]);
#pragma unroll
    for (int r = 0; r < 16; ++r) pmax = fmaxf(pmax, p1[r]);
    { auto rr = __builtin_amdgcn_permlane32_swap(__float_as_uint(pmax), __float_as_uint(pmax), false, false); pmax = fmaxf(__uint_as_float(rr[0]), __uint_as_float(rr[1])); }
    alpha = 1.f;
    if (FIRST) {
        const float dl = pmax; mhat += dl;
#pragma unroll
        for (int r = 0; r < 16; ++r) { p0[r] = __builtin_amdgcn_exp2f(p0[r] - dl); p1[r] -= dl; }
#pragma unroll
        for (int r = 0; r < 16; ++r) negm[r] = -mhat;
        asm volatile("" : "+v"(negm));
        alpha = __builtin_amdgcn_exp2f(-dl);
    } else {
#pragma unroll
        for (int r = 0; r < 16; ++r) p0[r] = __builtin_amdgcn_exp2f(p0[r]);
        if (__builtin_expect(__any(pmax > THR2), 0)) {
            const float dl = fmaxf(pmax, 0.f); mhat += dl; alpha = __builtin_amdgcn_exp2f(-dl);
#pragma unroll
            for (int r = 0; r < 16; ++r) { p0[r] *= alpha; p1[r] -= dl; }
#pragma unroll
            for (int r = 0; r < 16; ++r) negm[r] = -mhat;
            asm volatile("" : "+v"(negm));
        }
    }
}
__device__ __forceinline__ void finishSM(f32x16& p0, f32x16& p1, float alpha, float& l_reg, bf16x8& a0, bf16x8& a1, bf16x8& a2, bf16x8& a3) {
#pragma unroll
    for (int r = 0; r < 16; ++r) p1[r] = __builtin_amdgcn_exp2f(p1[r]);
    float sa = p0[0], sb = p1[0];
#pragma unroll
    for (int r = 1; r < 16; ++r) { sa += p0[r]; asm("" : "+v"(sa)); sb += p1[r]; asm("" : "+v"(sb)); }
    float ps = sa + sb;
    { auto rr = __builtin_amdgcn_permlane32_swap(__float_as_uint(ps), __float_as_uint(ps), false, false); ps = __uint_as_float(rr[0]) + __uint_as_float(rr[1]); }
    l_reg = l_reg * alpha + ps;
    PK4(p0, 0, a0); PK4(p0, 8, a1); PK4(p1, 0, a2); PK4(p1, 8, a3);
}

__device__ __forceinline__ void da_unit(bf16_t* proj, int tok0, int seq, int h, int qb, int ntok0, int nh, int nqb, bool first, bool has_next, bf16x8 (&qn)[4],
                                        float lam, const float* subg, float osc, LAS unsigned char* lds, unsigned lds0) {
    constexpr int LDP = 3072;
    int tid = threadIdx.x; asm volatile("" : "+v"(tid));
    const int wid = __builtin_amdgcn_readfirstlane(tid >> 6), lane = tid & 63, r32 = lane & 31, hi = lane >> 5;
    const int rg = wid & 3, map = wid >> 2;
    const bf16_t* Qw = proj + (size_t)(tok0 + qb * 128 + rg * 32 + r32) * LDP + h * 128 + map * 64 + hi * 8;
    const bf16_t* Kh = proj + (size_t)tok0 * LDP + 1024 + h * 128;
    const bf16_t* Vh = proj + (size_t)tok0 * LDP + 2048 + h * 128;
    int koff[2], voff[2];
#pragma unroll
    for (int i = 0; i < 2; ++i) { const int L = (i * 8 + wid) * 1024 + lane * 16;
        { const int row = L >> 8, pc = L & 255, lc = pc ^ ((row & 15) << 4); koff[i] = row * LDP + (lc >> 1); }
        { const int sub = L >> 9, k = (sub >> 2) * 8 + ((L & 511) >> 6), col = (sub & 3) * 32 + ((L & 63) >> 1); voff[i] = k * LDP + col; } }
    LAS float* wsf = (LAS float*)(lds + 98304) + wid * 64;
#define DA_DMAK(t, boff) do { const size_t tb_ = (size_t)(t) * 64 * LDP; _Pragma("unroll") for (int i_ = 0; i_ < 2; ++i_) \
        glds16(Kh + tb_ + koff[i_], (unsigned)__builtin_amdgcn_readfirstlane(lds0 + (boff) + (i_ * 8 + wid) * 1024)); } while (0)
#define DA_DMAV(t, boff) do { const size_t tb_ = (size_t)(t) * 64 * LDP; _Pragma("unroll") for (int i_ = 0; i_ < 2; ++i_) \
        glds16(Vh + tb_ + voff[i_], (unsigned)__builtin_amdgcn_readfirstlane(lds0 + 49152 + (boff) + (i_ * 8 + wid) * 1024)); } while (0)
#define DA_WAITBAR(n) do { if ((n) == 4) asm volatile("s_waitcnt vmcnt(4) lgkmcnt(0)\n\ts_barrier" ::: "memory"); \
        else if ((n) == 2) asm volatile("s_waitcnt vmcnt(2) lgkmcnt(0)\n\ts_barrier" ::: "memory"); else WAIT_BAR(); } while (0)
    if (first) {
#pragma unroll
        for (int d0 = 0; d0 < 4; ++d0) asm volatile("global_load_dwordx4 %0, %1, off" : "=&v"(qn[d0]) : "v"(Qw + d0 * 16) : "memory");
        DA_DMAK(0, 0); DA_DMAK(1, 16384); DA_DMAV(0, 0); DA_DMAK(2, 32768); DA_DMAV(1, 16384);
    }
    float m1 = 0.f, l1 = 0.f;
    f32x16 negm = f32x16{}; asm volatile("" : "+v"(negm));
    f32x16 o1[4];
#pragma unroll
    for (int d = 0; d < 4; ++d) o1[d] = f32x16{};
    const int NT = seq / 64;
    const int vb0 = (int)lds0 + 49152 + v_rd_base(lane);
    const int kcb = map * 128 + hi * 16;
#define DA_QKT(P0, P1, boff) do { const LAS unsigned char* Kt_ = lds + (boff); bf16x8 kf_[4]; \
          \
        kf_[0] = *(const LAS bf16x8*)(Kt_ + KSWZ(r32, kcb)); kf_[1] = *(const LAS bf16x8*)(Kt_ + KSWZ(32 + r32, kcb)); \
        kf_[2] = *(const LAS bf16x8*)(Kt_ + KSWZ(r32, kcb + 32)); kf_[3] = *(const LAS bf16x8*)(Kt_ + KSWZ(32 + r32, kcb + 32)); SBAR(); \
        P0 = __builtin_amdgcn_mfma_f32_32x32x16_bf16(kf_[0], qr[0], negm, 0, 0, 0); P1 = __builtin_amdgcn_mfma_f32_32x32x16_bf16(kf_[1], qr[0], negm, 0, 0, 0); \
        P0 = __builtin_amdgcn_mfma_f32_32x32x16_bf16(kf_[2], qr[1], P0, 0, 0, 0); P1 = __builtin_amdgcn_mfma_f32_32x32x16_bf16(kf_[3], qr[1], P1, 0, 0, 0); \
        kf_[0] = *(const LAS bf16x8*)(Kt_ + KSWZ(r32, kcb + 64)); kf_[1] = *(const LAS bf16x8*)(Kt_ + KSWZ(32 + r32, kcb + 64)); \
        kf_[2] = *(const LAS bf16x8*)(Kt_ + KSWZ(r32, kcb + 96)); kf_[3] = *(const LAS bf16x8*)(Kt_ + KSWZ(32 + r32, kcb + 96)); SBAR(); \
        P0 = __builtin_amdgcn_mfma_f32_32x32x16_bf16(kf_[0], qr[2], P0, 0, 0, 0); P1 = __builtin_amdgcn_mfma_f32_32x32x16_bf16(kf_[1], qr[2], P1, 0, 0, 0); \
        P0 = __builtin_amdgcn_mfma_f32_32x32x16_bf16(kf_[2], qr[3], P0, 0, 0, 0); P1 = __builtin_amdgcn_mfma_f32_32x32x16_bf16(kf_[3], qr[3], P1, 0, 0, 0); } while (0)
#define DA_PV(boff) do { const int vb = vb0 + (boff); _Pragma("unroll") for (int d0 = 0; d0 < 4; ++d0) { \
            s16x4 l0_, h0_, l1_, h1_, l2_, h2_, l3_, h3_; \
            TR_READ(l0_, vb, d0 * 512 + 0 * 4096); TR_READ(h0_, vb, d0 * 512 + 0 * 4096 + 2048); \
            TR_READ(l1_, vb, d0 * 512 + 1 * 4096); TR_READ(h1_, vb, d0 * 512 + 1 * 4096 + 2048); \
            TR_READ(l2_, vb, d0 * 512 + 2 * 4096); TR_READ(h2_, vb, d0 * 512 + 2 * 4096 + 2048); \
            TR_READ(l3_, vb, d0 * 512 + 3 * 4096); TR_READ(h3_, vb, d0 * 512 + 3 * 4096 + 2048); \
            asm volatile("s_waitcnt lgkmcnt(0)" ::: "memory"); SBAR(); \
            o1[d0] = __builtin_amdgcn_mfma_f32_32x32x16_bf16(pa0, PKV(l0_, h0_), o1[d0], 0, 0, 0); \
            o1[d0] = __builtin_amdgcn_mfma_f32_32x32x16_bf16(pa1, PKV(l1_, h1_), o1[d0], 0, 0, 0); \
            o1[d0] = __builtin_amdgcn_mfma_f32_32x32x16_bf16(pa2, PKV(l2_, h2_), o1[d0], 0, 0, 0); \
            o1[d0] = __builtin_amdgcn_mfma_f32_32x32x16_bf16(pa3, PKV(l3_, h3_), o1[d0], 0, 0, 0); } } while (0)
#define DA_RESC(a) do { if (__any((a) < 1.f)) { if (hi == 0) wsf[r32] = (a); asm volatile("s_waitcnt lgkmcnt(0)" ::: "memory"); \
        _Pragma("unroll") for (int d = 0; d < 4; ++d) _Pragma("unroll") for (int r = 0; r < 16; ++r) o1[d][r] *= wsf[crow(r, hi)]; } } while (0)
    f32x16 pA0, pA1, pB0, pB1; float alA, alB; bf16x8 pa0, pa1, pa2, pa3;
    asm volatile("s_waitcnt vmcnt(8)\n\ts_barrier" : "+v"(qn[0]), "+v"(qn[1]), "+v"(qn[2]), "+v"(qn[3]) :: "memory");
    bf16x8 qr[4];
#pragma unroll
    for (int d0 = 0; d0 < 4; ++d0) qr[d0] = qn[d0];
    DA_QKT(pA0, pA1, 0); partialSM<true>(pA0, pA1, m1, negm, alA); alA = 1.f;
    int cur = 0, nxt = 16384, nn = 32768;
    for (int j = 0; j < NT; j += 2) {
        DA_WAITBAR(2 * (j + 2 < NT) + 2 * (j + 1 < NT));
        if (j + 3 < NT) DA_DMAK(j + 3, cur);
        if (j + 2 < NT) DA_DMAV(j + 2, nn);
        SBAR(); DA_QKT(pB0, pB1, nxt);
        finishSM(pA0, pA1, alA, l1, pa0, pa1, pa2, pa3); SBAR();
        DA_PV(cur); partialSM<false>(pB0, pB1, m1, negm, alB);
        DA_RESC(alB);
        { const int t_ = cur; cur = nxt; nxt = nn; nn = t_; }
        DA_WAITBAR(2 * (j + 3 < NT) + 2 * (j + 2 < NT));
        if (j + 4 < NT) DA_DMAK(j + 4, cur);
        if (j + 3 < NT) DA_DMAV(j + 3, nn);
        SBAR(); if (j + 2 < NT) DA_QKT(pA0, pA1, nxt);
        finishSM(pB0, pB1, alB, l1, pa0, pa1, pa2, pa3); SBAR();
        DA_PV(cur); if (j + 2 < NT) { partialSM<false>(pA0, pA1, m1, negm, alA); DA_RESC(alA); }
        { const int t_ = cur; cur = nxt; nxt = nn; nn = t_; }
    }
#undef DA_WAITBAR
#undef DA_QKT
#undef DA_PV
#undef DA_RESC
    WAIT_BAR();
    if (has_next) {
        const bf16_t* nQw = proj + (size_t)(ntok0 + nqb * 128 + rg * 32 + r32) * LDP + nh * 128 + map * 64 + hi * 8;
        Kh = proj + (size_t)ntok0 * LDP + 1024 + nh * 128; Vh = proj + (size_t)ntok0 * LDP + 2048 + nh * 128;
#pragma unroll
        for (int d0 = 0; d0 < 4; ++d0) asm volatile("global_load_dwordx4 %0, %1, off" : "=&v"(qn[d0]) : "v"(nQw + d0 * 16) : "memory");
        DA_DMAK(0, 0); DA_DMAK(1, 16384); DA_DMAV(0, 0); DA_DMAK(2, 32768); DA_DMAV(1, 16384);
    }
#undef DA_DMAK
#undef DA_DMAV
    if (hi == 0) wsf[r32] = (map == 0 ? 1.f : lam) / l1;
    asm volatile("s_waitcnt lgkmcnt(0)" ::: "memory");
#pragma unroll
    for (int r = 0; r < 16; ++r) { const float ra = wsf[crow(r, hi)];
#pragma unroll
        for (int d = 0; d < 4; ++d) o1[d][r] *= ra; }
    LAS unsigned* xch = (LAS unsigned*)(lds + (rg < 2 ? 81920 + rg * 8192 : 100352 + (rg - 2) * 8192));
    if (map == 1) {
#pragma unroll
        for (int d = 0; d < 4; ++d)
#pragma unroll
            for (int r = 0; r < 16; r += 2) xch[(d * 8 + (r >> 1)) * 64 + lane] = cvt_pk_bf16(o1[d][r], o1[d][r + 1]);
    }
    asm volatile("s_waitcnt lgkmcnt(0)\n\ts_barrier" ::: "memory");
    if (map == 0) {
        float ss[16];
#pragma unroll
        for (int d = 0; d < 4; ++d)
#pragma unroll
            for (int r = 0; r < 16; r += 2) { const unsigned w = xch[(d * 8 + (r >> 1)) * 64 + lane];
                o1[d][r] -= __uint_as_float(w << 16); o1[d][r + 1] -= __uint_as_float(w & 0xffff0000u); }
#pragma unroll
        for (int r = 0; r < 16; ++r) { float s = 0.f;
#pragma unroll
            for (int d = 0; d < 4; ++d) s += o1[d][r] * o1[d][r];
            ss[r] = s; }
#pragma unroll
        for (int r = 0; r < 16; ++r) {
            float v_ = ss[r];
            v_ += __builtin_bit_cast(float, __builtin_amdgcn_update_dpp(0, __builtin_bit_cast(int, v_), 0xB1, 0xF, 0xF, true));
            v_ += __builtin_bit_cast(float, __builtin_amdgcn_update_dpp(0, __builtin_bit_cast(int, v_), 0x4E, 0xF, 0xF, true));
            v_ += __builtin_bit_cast(float, __builtin_amdgcn_update_dpp(0, __builtin_bit_cast(int, v_), 0x141, 0xF, 0xF, true));
            v_ += __builtin_bit_cast(float, __builtin_amdgcn_update_dpp(0, __builtin_bit_cast(int, v_), 0x140, 0xF, 0xF, true));
            v_ += __builtin_bit_cast(float, __builtin_amdgcn_ds_bpermute((lane ^ 16) << 2, __builtin_bit_cast(int, v_)));
            ss[r] = osc / sqrtf(v_ * (1.f / 128.f) + LN_EPS); }
        float gsub[4];
#pragma unroll
        for (int d = 0; d < 4; ++d) gsub[d] = subg[d * 32 + r32];
        asm volatile("s_waitcnt lgkmcnt(0)" ::: "memory");
        LAS bf16_t* stg = (LAS bf16_t*)xch;
#pragma unroll
        for (int r = 0; r < 16; ++r) { const int orow = crow(r, hi);
#pragma unroll
            for (int d = 0; d < 4; ++d) stg[orow * 128 + d * 32 + r32] = (bf16_t)(cvt_pk_bf16(o1[d][r] * ss[r] * gsub[d], 0.f) & 0xffffu); }
        asm volatile("s_waitcnt lgkmcnt(0)" ::: "memory");
        bf16_t* Ow = proj + (size_t)(tok0 + qb * 128 + rg * 32) * LDP + h * 128;
#pragma unroll
        for (int i = 0; i < 8; ++i) { const int p = i * 64 + lane, row = p >> 4, ch = p & 15;
            const u32x4 v = *(const LAS u32x4*)(stg + row * 128 + ch * 8); *(u32x4*)(Ow + (size_t)row * LDP + ch * 8) = v; }
    }
    asm volatile("s_waitcnt lgkmcnt(0)\n\ts_barrier" ::: "memory");
}

#define DL_PV(KB0) do { _Pragma("unroll") for (int d0 = 0; d0 < 2; ++d0) { _Pragma("unroll") for (int cq = 0; cq < 10; cq += 2) { s16x4 la_, ha_, lb_, hb_; \
        TR_READ(la_, vb, ((2 * (KB0) + cq) >> 2) * 8192 + ((((2 * (KB0) + cq) & 3) * 2 + 0) * 2 + d0) * 512); TR_READ(ha_, vb, ((2 * (KB0) + cq) >> 2) * 8192 + ((((2 * (KB0) + cq) & 3) * 2 + 1) * 2 + d0) * 512); \
        TR_READ(lb_, vb, ((2 * (KB0) + cq + 1) >> 2) * 8192 + ((((2 * (KB0) + cq + 1) & 3) * 2 + 0) * 2 + d0) * 512); TR_READ(hb_, vb, ((2 * (KB0) + cq + 1) >> 2) * 8192 + ((((2 * (KB0) + cq + 1) & 3) * 2 + 1) * 2 + d0) * 512); \
        asm volatile("s_waitcnt lgkmcnt(0)" ::: "memory"); SBAR(); \
        o[d0] = __builtin_amdgcn_mfma_f32_32x32x16_bf16(pa[cq], PKV(la_, ha_), o[d0], 0, 0, 0); \
        o[d0] = __builtin_amdgcn_mfma_f32_32x32x16_bf16(pa[cq + 1], PKV(lb_, hb_), o[d0], 0, 0, 0); } } } while (0)
__device__ __forceinline__ void dl_unit(bf16_t* proj, float* lse, int g, int dil, int ltok0, int Lsub, int rres, int qc, int h, LAS unsigned char* lds, unsigned lds0) {
    constexpr int LDP = 9216; constexpr int KOFF = 0, VOFF = 49152;
    int tid = threadIdx.x; asm volatile("" : "+v"(tid));
    const int wid = __builtin_amdgcn_readfirstlane(tid >> 6), lane = tid & 63, r32 = lane & 31, hi = lane >> 5;
    const int colQ = g * 3072 + h * 64, colK = colQ + 1024, colV = colQ + 2048;
    const int nl = wid >> 1, qbk = wid & 1;
    const int mq = qc * 256 + nl * 64 + qbk * 32;
    const int mk0 = qc * 256 - 64;
#pragma unroll
    for (int i = 0; i < 6; ++i) { const int L = (i * 8 + wid) * 1024 + lane * 16;
        const int row = L >> 7, pg = (L & 127) >> 4, lg = pg ^ ((row >> 1) & 7); int mk = mk0 + row; mk = mk < 0 ? 0 : (mk >= Lsub ? Lsub - 1 : mk);
        glds16(proj + (size_t)(ltok0 + mk * dil + rres) * LDP + colK + lg * 8, (unsigned)__builtin_amdgcn_readfirstlane(lds0 + KOFF + (i * 8 + wid) * 1024)); }
    bf16x8 qr[4];
    { const bf16_t* Qw = proj + (size_t)(ltok0 + (mq + r32) * dil + rres) * LDP + colQ + hi * 8;
#pragma unroll
      for (int d0 = 0; d0 < 4; ++d0) asm volatile("global_load_dwordx4 %0, %1, off" : "=&v"(qr[d0]) : "v"(Qw + d0 * 16) : "memory"); }
#pragma unroll
    for (int i = 0; i < 6; ++i) { const int L = (i * 8 + wid) * 1024 + lane * 16;
        const int tile = L >> 13, Lt = L & 8191, sub = Lt >> 9, k = (sub >> 1) * 8 + ((Lt & 511) >> 6), col = (sub & 1) * 32 + ((Lt & 63) >> 1);
        int mk = mk0 + tile * 64 + k; mk = mk < 0 ? 0 : (mk >= Lsub ? Lsub - 1 : mk);
        glds16(proj + (size_t)(ltok0 + mk * dil + rres) * LDP + colV + col, (unsigned)__builtin_amdgcn_readfirstlane(lds0 + VOFF + (i * 8 + wid) * 1024)); }
    asm volatile("s_waitcnt vmcnt(6)\n\ts_barrier" : "+v"(qr[0]), "+v"(qr[1]), "+v"(qr[2]), "+v"(qr[3]) :: "memory");
    f32x16 p[5];
#pragma unroll
    for (int kk = 0; kk < 5; ++kk) { p[kk] = f32x16{}; const int krow = nl * 64 + (qbk + kk) * 32 + r32; const int sw = (krow >> 1) & 7;
        bf16x8 kf[4];
#pragma unroll
        for (int d0 = 0; d0 < 4; ++d0) kf[d0] = *(const LAS bf16x8*)(lds + KOFF + krow * 128 + (((2 * d0 + hi) ^ sw) << 4));
        SBAR();
#pragma unroll
        for (int d0 = 0; d0 < 4; ++d0) p[kk] = __builtin_amdgcn_mfma_f32_32x32x16_bf16(kf[d0], qr[d0], p[kk], 0, 0, 0); }
#pragma unroll
    for (int r = 0; r < 16; ++r) { const int c = crow(r, hi); p[0][r] = (c >= r32) ? p[0][r] : -1e30f; p[4][r] = (c <= r32) ? p[4][r] : -1e30f; }
    if (mk0 < 0 || mk0 + 384 > Lsub) {
        const int kpos0 = mk0 + nl * 64 + qbk * 32;
#pragma unroll
        for (int kk = 0; kk < 5; ++kk)
#pragma unroll
            for (int r = 0; r < 16; ++r) { const int kpos = kpos0 + kk * 32 + crow(r, hi); p[kk][r] = (kpos >= 0 && kpos < Lsub) ? p[kk][r] : -1e30f; }
    }
    float pmax = -1e30f;
#pragma unroll
    for (int kk = 0; kk < 5; ++kk)
#pragma unroll
        for (int r = 0; r < 16; ++r) pmax = fmaxf(pmax, p[kk][r]);
    { auto rr = __builtin_amdgcn_permlane32_swap(__float_as_uint(pmax), __float_as_uint(pmax), false, false); pmax = fmaxf(__uint_as_float(rr[0]), __uint_as_float(rr[1])); }
    float ps = 0.f;
#pragma unroll
    for (int kk = 0; kk < 5; ++kk)
#pragma unroll
        for (int r = 0; r < 16; ++r) { p[kk][r] = __builtin_amdgcn_exp2f(p[kk][r] - pmax); ps += p[kk][r]; }
    { auto rr = __builtin_amdgcn_permlane32_swap(__float_as_uint(ps), __float_as_uint(ps), false, false); ps = __uint_as_float(rr[0]) + __uint_as_float(rr[1]); }
    if (hi == 0) lse[((size_t)g * 16384 + (size_t)(ltok0 + (mq + r32) * dil + rres)) * 16 + h] = pmax + __builtin_amdgcn_logf(ps);
    bf16x8 pa[10];
#pragma unroll
    for (int kk = 0; kk < 5; ++kk) { PK4(p[kk], 0, pa[2 * kk]); PK4(p[kk], 8, pa[2 * kk + 1]); }
    f32x16 o[2]; o[0] = f32x16{}; o[1] = f32x16{};
    const int vb = (int)lds0 + VOFF + nl * 8192 + v_rd_base(lane);
    WAIT_BAR();
    if (qbk == 0) DL_PV(0); else DL_PV(1);
    LAS float* wsf = (LAS float*)(lds + 98304) + wid * 64;
    if (hi == 0) wsf[r32] = 1.f / ps;
    asm volatile("s_waitcnt lgkmcnt(0)" ::: "memory");
    LAS bf16_t* stg = (LAS bf16_t*)(lds + KOFF + wid * 4096);
#pragma unroll
    for (int r = 0; r < 16; ++r) { const float ri = wsf[crow(r, hi)];
#pragma unroll
        for (int d0 = 0; d0 < 2; ++d0) stg[crow(r, hi) * 64 + d0 * 32 + r32] = (bf16_t)(cvt_pk_bf16(o[d0][r] * ri, 0.f) & 0xffffu); }
    asm volatile("s_waitcnt lgkmcnt(0)" ::: "memory");
#pragma unroll
    for (int i = 0; i < 4; ++i) { const int p = i * 64 + lane, row = p >> 3, ch = p & 7;
        const u32x4 v = *(const LAS u32x4*)(stg + row * 64 + ch * 8);
        *(u32x4*)(proj + (size_t)(ltok0 + (mq + row) * dil + rres) * LDP + colQ + ch * 8) = v; }
    WAIT_BAR();
}

__device__ __forceinline__ void da_decode(int i, int x, int jj, int& tok0, int& seq, int& h, int& qb) {
    if (i < 8) { const int sh = (i >> 1) * 8 + x; tok0 = (sh >> 3) * 8192; seq = 8192; h = sh & 7; qb = jj + 32 * (i & 1); }
    else { const int sh = (i - 8) * 8 + x; tok0 = TP + (sh >> 3) * 4096; seq = 4096; h = sh & 7; qb = jj; }
}
__global__ void __launch_bounds__(512, 2) fwd_mega(Params P) {
    extern __shared__ __attribute__((aligned(16))) unsigned char lds_raw[];
    cg::grid_group grid = cg::this_grid();
    LAS unsigned char* lds = (LAS unsigned char*)lds_raw;
    const unsigned lds0 = (unsigned)(uintptr_t)lds_raw;
    unsigned char* ws = P.ws;
    float* X = P.out;
    const bf16_t* XS = (const bf16_t*)P.out + (size_t)T * DM;
    bf16_t* BIG = (bf16_t*)(ws + WS_BIG);
    const float* rope = (const float*)(ws + WS_ROPE);
    const int bx = blockIdx.x; __builtin_assume(bx >= 0 && bx < NG);

    if (threadIdx.x < 2) ((volatile LAS unsigned*)(lds + LDS_TAB + 1024))[threadIdx.x] = 0u;
    __syncthreads();
    if (blockIdx.x == 0) for (int w = threadIdx.x; w < 4096; w += 512) ((unsigned*)(ws + WS_BAR))[w] = 0u;
    prologue(P, lds);
    grid.sync();
    (void)xcd_barrier_post((unsigned*)(ws + WS_BAR), (volatile LAS unsigned*)(lds + LDS_TAB + 1024));
#define GSYNC() do { XcdBarrier xb_; xb_.bar = (unsigned*)(P.ws + WS_BAR); xb_.x = xb_xcc_id(); xb_.st = (volatile LAS unsigned*)(lds + LDS_TAB + 1024); xcd_barrier(xb_); } while (0)

    for (int layer = 0; layer < 4; ++layer) {
        const int jl = layer >> 1;
        if ((layer & 1) == 0) {
            { pg8::SchedDense S; S.init(T, 3072, NG, bx, XS, DM, (bf16_t*)(ws + W_DAIN) + (size_t)jl * 3072 * 1024, DM);
              pg8::EpiProj E{BIG, 3072, rope, 0};
              pg8::gemm_phase<true>(lds, DM, DM, DM, S, E); }
            GSYNC();
            {
                const float lambda_init = 0.8f - 0.6f * expf(-0.3f * (float)layer);
                float d1 = 0.f, d2 = 0.f;
                for (int k = 0; k < 64; ++k) { d1 += P.in[4][jl * 64 + k] * P.in[5][jl * 64 + k]; d2 += P.in[6][jl * 64 + k] * P.in[7][jl * 64 + k]; }
                const float lam = expf(d1) - expf(d2) + lambda_init;
                const float* subg = P.in[8] + jl * 128;
                const int x = bx & 7, jj = bx >> 3;
                bf16x8 qn[4];
                for (int i = 0; i < 12; ++i) {
                    int tok0, seq, h, qb, ntok0, nseq, nh, nqb;
                    da_decode(i, x, jj, tok0, seq, h, qb); da_decode(i < 11 ? i + 1 : i, x, jj, ntok0, nseq, nh, nqb);
                    da_unit(BIG, tok0, seq, h, qb, ntok0, nh, nqb, i == 0, i < 11, qn, lam, subg, 1.f - lambda_init, lds, lds0);
                }
            }
            GSYNC();
            { pg8::SchedDense S; S.init(T, DM, NG, bx, BIG, 3072, (bf16_t*)(ws + W_DAOUT) + (size_t)jl * 1024 * 1024, DM);
              pg8::EpiRes E{(const unsigned short*)P.out + (size_t)T * DM, (unsigned short*)P.out, 0};
              pg8::gemm_phase<false>(lds, DM, 3072, DM, S, E); }
            GSYNC();
        } else {
            float* lse = (float*)(ws + WS_LSE);
            for (int ch = 0; ch < 3; ++ch) {
                { pg8::SchedDense S; S.init(16384, 9216, NG, bx, XS + (size_t)ch * 16384 * DM, DM, (bf16_t*)(ws + W_DLIN) + (size_t)jl * 9216 * 1024, DM);
                  pg8::EpiProj E{BIG, 9216, rope, ch * 16384};
                  pg8::gemm_phase<true>(lds, DM, DM, DM, S, E); }
                GSYNC();
                {
                    const int Sq = (ch < 2) ? 8192 : 4096, spc = Sq >> 8;
                    for (int i = 0; i < 12; ++i) {
                        const int u = i * NG + bx, h = u & 15, rest = u >> 4, g = rest >> 6, cm = rest & 63;
                        const int sl = cm / spc, idx = cm % spc, dil = (g == 0) ? 1 : (g == 1 ? 4 : 16), Lsub = Sq / dil, cps = Lsub >> 8;
                        const int rres = idx / cps, qc = idx % cps;
                        dl_unit(BIG, lse, g, dil, sl * Sq, Lsub, rres, qc, h, lds, lds0);
                    }
                }
                GSYNC();
                int tidc = threadIdx.x; asm volatile("" : "+v"(tidc));
                for (int idx = bx * 512 + tidc; idx < 16384 * 128; idx += NG * 512) {
                    const int tl = idx >> 7, c8 = idx & 127, hh = c8 >> 3;
                    const float l0 = lse[((size_t)0 * 16384 + tl) * 16 + hh], l1 = lse[((size_t)1 * 16384 + tl) * 16 + hh], l2 = lse[((size_t)2 * 16384 + tl) * 16 + hh];
                    const float mx = fmaxf(l0, fmaxf(l1, l2));
                    float w0 = __builtin_amdgcn_exp2f(l0 - mx), w1 = __builtin_amdgcn_exp2f(l1 - mx), w2 = __builtin_amdgcn_exp2f(l2 - mx);
                    const float inv = 1.f / (w0 + w1 + w2); w0 *= inv; w1 *= inv; w2 *= inv;
                    const u32x4 a = *(const u32x4*)(BIG + (size_t)tl * 9216 + c8 * 8), b = *(const u32x4*)(BIG + (size_t)tl * 9216 + 3072 + c8 * 8), c = *(const u32x4*)(BIG + (size_t)tl * 9216 + 6144 + c8 * 8);
                    u32x4 o;
#pragma unroll
                    for (int e = 0; e < 4; ++e) {
                        const float lo = w0 * __uint_as_float(a[e] << 16) + w1 * __uint_as_float(b[e] << 16) + w2 * __uint_as_float(c[e] << 16);
                        const float hi_ = w0 * __uint_as_float(a[e] & 0xffff0000u) + w1 * __uint_as_float(b[e] & 0xffff0000u) + w2 * __uint_as_float(c[e] & 0xffff0000u);
                        o[e] = cvt_pk_bf16(lo, hi_); }
                    *(u32x4*)(BIG + (size_t)tl * 9216 + c8 * 8) = o;
                }
                GSYNC();
                { pg8::SchedDense S; S.init(16384, DM, NG, bx, BIG, 9216, (bf16_t*)(ws + W_DLOUT) + (size_t)jl * 1024 * 1024, DM);
                  pg8::EpiRes E{(const unsigned short*)P.out + (size_t)T * DM, (unsigned short*)P.out, ch * 16384};
                  pg8::gemm_phase<false>(lds, DM, 9216, DM, S, E); }
                GSYNC();
            }
        }
        phase_ln1_router(P, layer, lds);
        GSYNC();
        phase_gather(P, layer, lds);
        GSYNC();
        { const char* strm = (layer == 3) ? (const char*)(ws + WS_XB) : (const char*)((const bf16_t*)P.out + (size_t)T * DM);
          pg8::SchedMoE<true> S{(LAS int*)(lds + LDS_TAB + 4096), (const int*)(ws + WS_ROWI), (const LAS int*)(lds + LDS_TAB), NG, bx, strm, (const char*)((bf16_t*)(ws + W_GU) + (size_t)layer * 16 * 1024 * 1024),
                          (size_t)0, (size_t)256 * DM * 2, (size_t)1024 * 1024 * 2};
          pg8::EpiGU E{(bf16_t*)(ws + BIG_H), (const float*)(ws + WS_ROWW)};
          pg8::gemm_phase<true>(lds, DM, DM, DM, S, E); }
        GSYNC();
        { pg8::SchedMoE<false> S{nullptr, nullptr, (const LAS int*)(lds + LDS_TAB), NG, bx, (const char*)(ws + BIG_H), (const char*)((bf16_t*)(ws + W_DN) + (size_t)layer * 16 * 1024 * 512),
                          (size_t)256 * 512 * 2, (size_t)256 * 512 * 2, (size_t)1024 * 512 * 2};
          pg8::EpiDown E{BIG, (const int*)(ws + WS_ROWI)};
          pg8::gemm_phase<false>(lds, 512, 512, 512, S, E); }
        GSYNC();
        phase_ln2(P, layer);
        GSYNC();
    }
}

extern "C" void kernel_launch(void* const* d_in, const int* in_sizes, int n_in, void* d_out, int out_size, void* d_ws, size_t ws_size, hipStream_t stream) {
    static int ready = 0;
    if (ready == 0) {
        if (n_in != 20 || out_size != T * DM || ws_size < WS_END) { fprintf(stderr, "kernel_launch: unexpected shapes (n_in %d out %d ws %zu, need %zu)\n", n_in, out_size, ws_size, (size_t)WS_END); ready = -1; return; }
        if (hipFuncSetAttribute((const void*)fwd_mega, hipFuncAttributeMaxDynamicSharedMemorySize, LDS_BYTES) != hipSuccess) { fprintf(stderr, "kernel_launch: hipFuncSetAttribute failed\n"); ready = -1; return; }
        int per_cu = 0;
        if (hipOccupancyMaxActiveBlocksPerMultiprocessor(&per_cu, (const void*)fwd_mega, 512, LDS_BYTES) != hipSuccess || per_cu < 1) fprintf(stderr, "kernel_launch: occupancy query says %d\n", per_cu);
        (void)hipGetLastError();
        ready = 1;
    }
    if (ready < 0) return;
    Params p{};
    for (int i = 0; i < 20; ++i) p.in[i] = (const float*)d_in[i];
    p.out = (float*)d_out; p.ws = (unsigned char*)d_ws;
    void* args[] = {&p};
    hipError_t e = hipLaunchCooperativeKernel((const void*)fwd_mega, dim3(NG), dim3(512), args, LDS_BYTES, stream);
    if (e != hipSuccess) fprintf(stderr, "cooperative launch failed: %s\n", hipGetErrorString(e));
}
```

```cpp
#include <hip/hip_runtime.h>
#include <hip/hip_cooperative_groups.h>
#include <cstdio>
#include <cstdint>
namespace cg = cooperative_groups;

#define LAS __attribute__((address_space(3)))
typedef unsigned short bf16_t;
typedef short bf16x8 __attribute__((ext_vector_type(8)));
typedef short s16x4 __attribute__((ext_vector_type(4)));
typedef float f32x4 __attribute__((ext_vector_type(4)));
typedef float f32x16 __attribute__((ext_vector_type(16)));
typedef unsigned u32x4 __attribute__((ext_vector_type(4)));
typedef unsigned u32x2 __attribute__((ext_vector_type(2)));
typedef _Float16 h16x8 __attribute__((ext_vector_type(8)));

constexpr int T = 49152, TP = 32768, DM = 1024;
constexpr int NG = 256;
constexpr int TPB = T / NG;
constexpr int MAXROWS = 2 * T + 16 * 256;
constexpr float LN_EPS = 1e-5f;
constexpr float ALPHA = 1.681792830507429f;
constexpr float C2 = 0.125f * 1.4426950408889634f;

constexpr size_t MiB = 1u << 20;
constexpr size_t WS_CNT = 0;
constexpr size_t WS_BAR = 65536;
constexpr size_t WS_ROPE = 1 * MiB;
constexpr size_t WS_TOK = 2 * MiB;
constexpr size_t WS_ROWI = 4 * MiB;
constexpr size_t WS_ROWW = 5 * MiB;
constexpr size_t WS_LSE = 6 * MiB;
constexpr size_t WS_W = 10 * MiB;
constexpr size_t W_DAIN = WS_W;
constexpr size_t W_DAOUT = W_DAIN + 12 * MiB;
constexpr size_t W_DLIN = W_DAOUT + 4 * MiB;
constexpr size_t W_DLOUT = W_DLIN + 36 * MiB;
constexpr size_t W_GU = W_DLOUT + 4 * MiB;
constexpr size_t W_DN = W_GU + 128 * MiB;
constexpr size_t WS_XB = W_DN + 64 * MiB;
constexpr size_t WS_BIG = WS_XB + 96 * MiB;
constexpr size_t BIG_H = WS_BIG + (size_t)MAXROWS * 2048;
constexpr size_t WS_END = WS_BIG + 300 * MiB;

constexpr int LDS_TAB = 131072;
constexpr int LDS_BYTES = 147456;

struct Params {
    const float* in[20];
    float* out;
    unsigned char* ws;
};

__device__ __forceinline__ unsigned cvt_pk_bf16(float lo, float hi) { unsigned r; asm("v_cvt_pk_bf16_f32 %0, %1, %2" : "=v"(r) : "v"(lo), "v"(hi)); return r; }
typedef _Float16 h16x2 __attribute__((ext_vector_type(2)));
typedef float f32x2_t __attribute__((ext_vector_type(2)));
__device__ __forceinline__ unsigned pk_h2(float lo, float hi) { const f32x2_t v = {lo, hi}; return __builtin_bit_cast(unsigned, __builtin_convertvector(v, h16x2)); }
__device__ __forceinline__ f32x2_t up_h2(unsigned w) { return __builtin_convertvector(__builtin_bit_cast(h16x2, w), f32x2_t); }
__device__ __forceinline__ float bf2f(unsigned short b) { return __uint_as_float(((unsigned)b) << 16); }
__device__ __forceinline__ float wave_sum(float v) {
#pragma unroll
    for (int o = 1; o < 64; o <<= 1) v += __shfl_xor(v, o);
    return v;
}
__device__ __forceinline__ float wave_allsum(float v) {
    v += __builtin_bit_cast(float, __builtin_amdgcn_update_dpp(0, __builtin_bit_cast(int, v), 0xB1, 0xF, 0xF, true));
    v += __builtin_bit_cast(float, __builtin_amdgcn_update_dpp(0, __builtin_bit_cast(int, v), 0x4E, 0xF, 0xF, true));
    v += __builtin_bit_cast(float, __builtin_amdgcn_update_dpp(0, __builtin_bit_cast(int, v), 0x141, 0xF, 0xF, true));
    v += __builtin_bit_cast(float, __builtin_amdgcn_update_dpp(0, __builtin_bit_cast(int, v), 0x140, 0xF, 0xF, true));
    const int vi = __builtin_bit_cast(int, v);
    return (__builtin_bit_cast(float, __builtin_amdgcn_readlane(vi, 0)) + __builtin_bit_cast(float, __builtin_amdgcn_readlane(vi, 16)))
         + (__builtin_bit_cast(float, __builtin_amdgcn_readlane(vi, 32)) + __builtin_bit_cast(float, __builtin_amdgcn_readlane(vi, 48)));
}
__device__ __forceinline__ int crow(int r, int hi) { return (r & 3) + 8 * (r >> 2) + 4 * hi; }
#define SBAR() __builtin_amdgcn_sched_barrier(0)
#define WAIT_BAR() asm volatile("s_waitcnt vmcnt(0) lgkmcnt(0)\n\ts_barrier" ::: "memory")
__device__ __forceinline__ void glds16(const void* gsrc, unsigned lds_dst) {
    unsigned keep;
    asm volatile("s_mov_b32 %0, m0\n\ts_mov_b32 m0, %2\n\ts_nop 0\n\tglobal_load_lds_dwordx4 %1, off\n\ts_mov_b32 m0, %0" : "=&s"(keep) : "v"(gsrc), "s"(lds_dst) : "memory");
}


#define XB_TMO      128
#define XB_XCNT(j)  (256  + 64 * (j))
#define XB_XSUB(j)  (1280 + 64 * (j))
#define XB_XGEN(j)  (2304 + 64 * (j))
#define XB_TOP      3328
#define XB_TOPGEN   3392
#define XCD_BAR_WORDS 3456
#define XB_SPIN_CAP (1u << 22)
__device__ __forceinline__ unsigned xb_ld(unsigned* p)              { return __hip_atomic_load(p, __ATOMIC_RELAXED, __HIP_MEMORY_SCOPE_AGENT); }
__device__ __forceinline__ unsigned xb_add(unsigned* p, unsigned v) { return __hip_atomic_fetch_add(p, v, __ATOMIC_RELAXED, __HIP_MEMORY_SCOPE_AGENT); }
__device__ __forceinline__ unsigned xb_xcc_id() { return (unsigned)__builtin_amdgcn_s_getreg((3 << 11) | 20) & 0xFu; }
#define XB_SPIN(cond, bar) do { unsigned _sp = 0; while (cond) { __builtin_amdgcn_s_sleep(1); \
    if ((++_sp & 255u) == 0u) { if (xb_ld(&(bar)[XB_TMO])) break; if (_sp > XB_SPIN_CAP) { atomicAdd(&(bar)[XB_TMO], 1u); break; } } } } while (0)
struct XcdBarrier { unsigned* bar; unsigned x; volatile LAS unsigned* st; };
__device__ __forceinline__ XcdBarrier xcd_barrier_post(unsigned* bar, volatile LAS unsigned* st) {
    XcdBarrier b; b.bar = bar; b.x = xb_xcc_id(); b.st = st;
    if (threadIdx.x == 0) (void)xb_add(&bar[XB_XCNT(b.x)], 1u);
    return b;
}
__device__ __forceinline__ void xcd_barrier_complete(unsigned* bar, unsigned x, unsigned& nloc, unsigned& nx) {
    const unsigned G = gridDim.x * gridDim.y * gridDim.z;
    unsigned sum, cnt, mine, sp = 0u;
    for (;;) {
        sum = 0u; cnt = 0u; mine = 0u;
#pragma unroll
        for (unsigned j = 0; j < 16; ++j) { const unsigned c = xb_ld(&bar[XB_XCNT(j)]); sum += c; cnt += (c > 0u) ? 1u : 0u; mine = (j == x) ? c : mine; }
        if (sum == G) break;
        __builtin_amdgcn_s_sleep(1);
        if ((++sp & 255u) == 0u) { if (xb_ld(&bar[XB_TMO])) break; if (sp > XB_SPIN_CAP) { atomicAdd(&bar[XB_TMO], 1u); break; } }
    }
    nloc = mine > 0u ? mine : 1u; nx = cnt > 0u ? cnt : 1u;
}
__device__ __forceinline__ void xcd_barrier(const XcdBarrier& b) {
    asm volatile("s_waitcnt vmcnt(0)" ::: "memory");
    __syncthreads();
    if (threadIdx.x == 0) {
        unsigned* bar = b.bar;
        __builtin_amdgcn_s_waitcnt(0);
        unsigned nloc = b.st[0], nx = b.st[1];
        if (nloc == 0u) { xcd_barrier_complete(bar, b.x, nloc, nx); b.st[0] = nloc; b.st[1] = nx; }
        const unsigned old = xb_add(&bar[XB_XSUB(b.x)], 1u);
        const unsigned gen = old / nloc;
        if (old + 1u == (gen + 1u) * nloc) {
            __builtin_amdgcn_fence(__ATOMIC_RELEASE, "agent");
            asm volatile("s_waitcnt vmcnt(0)" ::: "memory");
            const unsigned og = xb_add(&bar[XB_TOP], 1u);
            const unsigned tg = og / nx;
            if (og + 1u == (tg + 1u) * nx) xb_add(&bar[XB_TOPGEN], 1u);
            else XB_SPIN(xb_ld(&bar[XB_TOPGEN]) == tg, bar);
            __builtin_amdgcn_fence(__ATOMIC_ACQUIRE, "agent");
            xb_add(&bar[XB_XGEN(b.x)], 1u);
            asm volatile("s_waitcnt vmcnt(0)" ::: "memory");
        } else {
            XB_SPIN(xb_ld(&bar[XB_XGEN(b.x)]) == gen, bar);
            __builtin_amdgcn_fence(__ATOMIC_ACQUIRE, "agent");
            asm volatile("s_waitcnt vmcnt(0)" ::: "memory");
        }
    }
    __syncthreads();
}

namespace pg8 {
constexpr int BM = 256, BK = 64, HALF = 128, HTB = HALF * BK * 2, STAGE_BYTES = 8 * HTB;
__host__ __device__ __forceinline__ int lds_byte(int r, int c) { const int st = (r >> 4) * 2 + (c >> 5), rr = r & 15, cc = c & 31, ob = rr * 64 + cc * 2; return st * 1024 + (ob ^ (((ob >> 9) & 1) << 5)); }
__host__ __device__ __forceinline__ void stage_rc(int b, int& R, int& C) { const int st = b / 1024, sb = b % 1024, swz = sb ^ (((sb >> 9) & 1) << 5); R = (st >> 1) * 16 + swz / 64; C = (st & 1) * 32 + (swz % 64) / 2; }
__host__ __device__ __forceinline__ int perm32(int rho) { const int n = rho >> 4, i = rho & 15; return 8 * (i >> 2) + 4 * n + (i & 3); }

struct Unit { int pm, pn; const char* a; const char* b; };

template <bool F16, class Epi, class Sched>
__device__ __forceinline__ void gemm_phase(LAS unsigned char* lds, const int K, const int lda, const int ldb, const Sched& S, const Epi& E) {
    int tid = threadIdx.x; asm volatile("" : "+v"(tid));
    const int wid = __builtin_amdgcn_readfirstlane(tid >> 6), lane = tid & 63, wr = wid >> 2, wc = wid & 3, fr = lane & 15, fq = lane >> 4;
    const int nt = K / BK;
    unsigned voffA[2], voffB[2];
#pragma unroll
    for (int i = 0; i < 2; ++i) { int R, C; stage_rc(tid * 16 + i * 8192, R, C); const int Rb = (R & ~31) + perm32(R & 31);
        voffA[i] = (unsigned)(R * lda + C) * 2u; voffB[i] = (unsigned)(Rb * ldb + C) * 2u; }
    constexpr bool GA = Sched::GATHER;
    const size_t kstep = (size_t)(BK * 2);
    const size_t hstepA = GA ? (size_t)0 : (size_t)HALF * lda * 2, hstepB = (size_t)HALF * ldb * 2;
    unsigned go[2][2];
    go[0][0] = voffA[0]; go[0][1] = voffA[1]; go[1][0] = voffA[0]; go[1][1] = voffA[1];
#define PG8_GOLOAD(UI) do { int R0_, C0_; stage_rc(tid * 16, R0_, C0_); const LAS int* tb_ = S.tab + (UI) * 256; \
        go[0][0] = (unsigned)tb_[R0_] + (unsigned)(C0_ * 2); go[0][1] = (unsigned)tb_[R0_ + 64] + (unsigned)(C0_ * 2); \
        go[1][0] = (unsigned)tb_[128 + R0_] + (unsigned)(C0_ * 2); go[1][1] = (unsigned)tb_[128 + R0_ + 64] + (unsigned)(C0_ * 2); } while (0)
    const unsigned ldsw = (unsigned)wid * 1024u;
    const int aoff = lds_byte(wr * 64 + fr, fq * 8), boff = lds_byte(wc * 32 + fr, fq * 8);
#define PG8_SA(b, h) (((b) * 2 + (h)) * HTB)
#define PG8_SB(b, h) ((4 + (b) * 2 + (h)) * HTB)
#define PG8_STAGE(bufoff, gbase, voff) do { _Pragma("unroll") for (int _i = 0; _i < 2; ++_i) \
        __builtin_amdgcn_global_load_lds((const unsigned*)((const char*)(gbase) + (voff)[_i]), (LAS unsigned*)(lds + (bufoff) + ldsw + _i * 8192), 16, 0, 0); } while (0)
#define PG8_LDA(dst, b, h) do { _Pragma("unroll") for (int m = 0; m < 4; ++m) _Pragma("unroll") for (int k = 0; k < 2; ++k) dst[m][k] = *(const LAS bf16x8*)(lds + PG8_SA(b, h) + aoff + m * 2048 + k * 1024); } while (0)
#define PG8_LDB(dst, b, h) do { _Pragma("unroll") for (int n = 0; n < 2; ++n) _Pragma("unroll") for (int k = 0; k < 2; ++k) dst[n][k] = *(const LAS bf16x8*)(lds + PG8_SB(b, h) + boff + n * 2048 + k * 1024); } while (0)
#define PG8_MMA(ai, bj, At, Bt) do { __builtin_amdgcn_s_setprio(1); _Pragma("unroll") for (int m = 0; m < 4; ++m) _Pragma("unroll") for (int n = 0; n < 2; ++n) _Pragma("unroll") for (int k = 0; k < 2; ++k) \
        acc[ai][bj][m][n] = F16 ? __builtin_amdgcn_mfma_f32_16x16x32_f16(__builtin_bit_cast(h16x8, Bt[n][k]), __builtin_bit_cast(h16x8, At[m][k]), acc[ai][bj][m][n], 0, 0, 0) \
                                : __builtin_amdgcn_mfma_f32_16x16x32_bf16(Bt[n][k], At[m][k], acc[ai][bj][m][n], 0, 0, 0); __builtin_amdgcn_s_setprio(0); } while (0)
#define PG8_WAIT_V(n) asm volatile("s_waitcnt vmcnt(" #n ")" ::: "memory")
#define PG8_WAIT_L(n) asm volatile("s_waitcnt lgkmcnt(" #n ")" ::: "memory")
#define PG8_BAR __builtin_amdgcn_s_barrier()
#define PG8_SCHED __builtin_amdgcn_sched_barrier(0)
    Unit cur, nxt; int ui = 0;
    if constexpr (GA) {
        for (int e = tid; e < 8 * 256; e += 512) { Unit uu; if (S.next(e >> 8, uu)) { const int ri = S.rowinfo[uu.pm * BM + (e & 255)]; S.tab[e] = (ri < 0 ? 0 : (ri >> 1)) * (lda * 2); } }
        __syncthreads();
    }
    if (!S.next(0, cur)) return;
    if constexpr (GA) PG8_GOLOAD(0);
    f32x4 acc[2][2][4][2];
#pragma unroll
    for (int a = 0; a < 2; ++a)
#pragma unroll
        for (int b = 0; b < 2; ++b)
#pragma unroll
            for (int m = 0; m < 4; ++m)
#pragma unroll
                for (int n = 0; n < 2; ++n) acc[a][b][m][n] = (f32x4){0.f, 0.f, 0.f, 0.f};
    bf16x8 At[4][2], B0[2][2], B1[2][2];
    const char* cA = cur.a; const char* cB = cur.b;
    PG8_STAGE(PG8_SB(0, 0), cB, voffB); PG8_STAGE(PG8_SB(0, 1), cB + hstepB, voffB); PG8_STAGE(PG8_SA(0, 0), cA, go[0]); PG8_STAGE(PG8_SA(0, 1), cA + hstepA, go[1]);
    if (wr == 1) PG8_BAR;
    PG8_WAIT_V(2); PG8_BAR;
    PG8_STAGE(PG8_SB(1, 0), cB + kstep, voffB); PG8_STAGE(PG8_SA(1, 0), cA + kstep, go[0]); PG8_STAGE(PG8_SB(1, 1), cB + hstepB + kstep, voffB);
    PG8_WAIT_V(6); PG8_BAR;
    for (;;) {
        const bool has_next = S.next(ui + 1, nxt);
        const char* nA = has_next ? nxt.a : cA; const char* nB = has_next ? nxt.b : cB;
        for (int t = 0; t < nt; t += 2) {
            const bool last = (t == nt - 2);
            const char* a1 = cA + (size_t)(t + 1) * kstep;
            const char* a2 = last ? nA : cA + (size_t)(t + 2) * kstep; const char* b2 = last ? nB : cB + (size_t)(t + 2) * kstep;
            const char* a3 = a2 + kstep; const char* b3 = b2 + kstep;
            PG8_LDB(B0, 0, 0); PG8_LDB(B1, 0, 1); PG8_SCHED; PG8_LDA(At, 0, 0); PG8_STAGE(PG8_SA(1, 1), a1 + hstepA, go[1]);
            if constexpr (GA) { if (last && has_next) PG8_GOLOAD(ui + 1); }
            PG8_WAIT_V(8); PG8_WAIT_L(0); PG8_BAR; PG8_MMA(0, 0, At, B0); PG8_MMA(0, 1, At, B1); PG8_BAR; PG8_SCHED;
            PG8_LDA(At, 0, 1); PG8_STAGE(PG8_SB(0, 0), b2, voffB); PG8_STAGE(PG8_SB(0, 1), b2 + hstepB, voffB); PG8_STAGE(PG8_SA(0, 0), a2, go[0]);
            PG8_WAIT_V(8); PG8_WAIT_L(0); PG8_BAR; PG8_MMA(1, 0, At, B0); PG8_MMA(1, 1, At, B1); PG8_BAR; PG8_SCHED;
            PG8_LDB(B0, 1, 0); PG8_LDB(B1, 1, 1); PG8_SCHED; PG8_LDA(At, 1, 0); PG8_STAGE(PG8_SA(0, 1), a2 + hstepA, go[1]);
            PG8_WAIT_V(8); PG8_WAIT_L(0); PG8_BAR; PG8_MMA(0, 0, At, B0); PG8_MMA(0, 1, At, B1); PG8_BAR; PG8_SCHED;
            PG8_LDA(At, 1, 1); PG8_STAGE(PG8_SB(1, 0), b3, voffB); PG8_STAGE(PG8_SB(1, 1), b3 + hstepB, voffB); PG8_STAGE(PG8_SA(1, 0), a3, go[0]);
            PG8_WAIT_V(8); PG8_WAIT_L(0); PG8_BAR; PG8_MMA(1, 0, At, B0); PG8_MMA(1, 1, At, B1); PG8_BAR; PG8_SCHED;
        }
        if (wr == 0) PG8_BAR;
        E(acc, cur, wr, wc, fr, fq);
        if (!has_next) break;
#pragma unroll
        for (int a = 0; a < 2; ++a)
#pragma unroll
            for (int b = 0; b < 2; ++b)
#pragma unroll
                for (int m = 0; m < 4; ++m)
#pragma unroll
                    for (int n = 0; n < 2; ++n) acc[a][b][m][n] = (f32x4){0.f, 0.f, 0.f, 0.f};
        cur = nxt; cA = nA; cB = nB; ++ui;
        if (wr == 1) PG8_BAR;
    }
    PG8_WAIT_V(0);
    PG8_BAR;
#undef PG8_SA
#undef PG8_SB
#undef PG8_STAGE
#undef PG8_GOLOAD
#undef PG8_LDA
#undef PG8_LDB
#undef PG8_MMA
#undef PG8_WAIT_V
#undef PG8_WAIT_L
#undef PG8_BAR
#undef PG8_SCHED
}

struct SchedDense {
    static constexpr bool GATHER = false; LAS int* tab; const int* rowinfo;
    int nM, nN, nwg, G, c; const char* A; const char* B; size_t ta, tb;
    __device__ void init(int M, int N, int G_, int c_, const void* A_, int lda, const void* B_, int ldb) {
        nM = M / BM; nN = N / BM; nwg = nM * nN; G = G_; c = c_; A = (const char*)A_; B = (const char*)B_; ta = (size_t)BM * lda * 2; tb = (size_t)BM * ldb * 2; }
    __device__ bool next(int i, Unit& u) const {
        const long L = (long)i * G + c; if (L >= nwg) return false;
        int wgid = (int)L; { const int q = nwg / 8, r = nwg % 8, xcd = wgid % 8, off = wgid / 8; wgid = (xcd < r ? xcd * (q + 1) : r * (q + 1) + (xcd - r) * q) + off; }
        const int nig = 8 * nN, gid = wgid / nig, fm = gid * 8, gsz = (nM - fm) < 8 ? (nM - fm) : 8;
        u.pm = fm + ((wgid % nig) % gsz); u.pn = (wgid % nig) / gsz;
        u.a = A + (size_t)u.pm * ta; u.b = B + (size_t)u.pn * tb; return true;
    }
};
template <bool GATHER_>
struct SchedMoE {
    static constexpr bool GATHER = GATHER_; LAS int* tab; const int* rowinfo;
    const LAS int* off; int G, c; const char* A; const char* B; size_t ta, tb, eb;
    __device__ bool next(int i, Unit& u) const {
        const int ntile = off[16] >> 8; const int v = i * (G >> 3) + (c >> 3); const int m = (v >> 2) * 8 + (c & 7), pn = v & 3;
        if (m >= ntile) return false;
        const int row = m << 8; int b = 0;
#pragma unroll
        for (int k = 1; k < 16; ++k) b += (row >= off[k]) ? 1 : 0;
        u.pm = m; u.pn = pn; u.a = A + (size_t)m * ta; u.b = B + (size_t)b * eb + (size_t)pn * tb; return true;
    }
};

struct EpiProj {
    bf16_t* O; int ldc; const float* rope; int rowbase;
    __device__ __forceinline__ void operator()(const f32x4 (&acc)[2][2][4][2], const Unit& u, int wr, int wc, int fr, int fq) const {
        const int typ = ((u.pn * BM) % 3072) >> 10;
        const float sc = (typ == 0) ? C2 : 1.f;
        const bool dorope = (typ < 2) && ((wc & 1) == 0);
        const int row0 = u.pm * BM + wr * 64 + fr, col0 = u.pn * BM + wc * 32 + 8 * fq;
#pragma unroll
        for (int ai = 0; ai < 2; ++ai)
#pragma unroll
            for (int m = 0; m < 4; ++m) {
                const int row = row0 + ai * HALF + m * 16;
                f32x4 t0 = {1.f, 0.f, 1.f, 0.f}, t1 = t0;
                if (dorope && fq < 2) { const int tok = rowbase + row; const int pos = tok < TP ? (tok & 8191) : (tok & 4095);
                    const f32x4* tp = (const f32x4*)(rope + (size_t)pos * 16 + 8 * fq); t0 = tp[0]; t1 = tp[1]; }
                bf16_t* rowp = O + (size_t)row * ldc + col0;
#pragma unroll
                for (int bj = 0; bj < 2; ++bj) {
                    f32x4 v0 = acc[ai][bj][m][0], v1 = acc[ai][bj][m][1];
                    if (dorope && fq < 2) {
                        const f32x4 a = v0, b = v1;
                        v0[0] = a[0] * t0[0] - b[0] * t0[1]; v1[0] = b[0] * t0[0] + a[0] * t0[1];
                        v0[1] = a[1] * t0[2] - b[1] * t0[3]; v1[1] = b[1] * t0[2] + a[1] * t0[3];
                        v0[2] = a[2] * t1[0] - b[2] * t1[1]; v1[2] = b[2] * t1[0] + a[2] * t1[1];
                        v0[3] = a[3] * t1[2] - b[3] * t1[3]; v1[3] = b[3] * t1[2] + a[3] * t1[3];
                    }
                    v0 = v0 * sc; v1 = v1 * sc;
                    u32x4 w; w.x = cvt_pk_bf16(v0[0], v0[1]); w.y = cvt_pk_bf16(v0[2], v0[3]); w.z = cvt_pk_bf16(v1[0], v1[1]); w.w = cvt_pk_bf16(v1[2], v1[3]);
                    *(u32x4*)(rowp + bj * HALF) = w;
                }
            }
    }
};
struct EpiRes {
    const unsigned short* XH; unsigned short* Z; int rowbase;
    __device__ __forceinline__ void operator()(const f32x4 (&acc)[2][2][4][2], const Unit& u, int wr, int wc, int fr, int fq) const {
        const int row0 = rowbase + u.pm * BM + wr * 64 + fr, col0 = u.pn * BM + wc * 32 + 8 * fq;
#pragma unroll
        for (int ai = 0; ai < 2; ++ai)
#pragma unroll
            for (int m = 0; m < 4; ++m) {
                const size_t ro = (size_t)(row0 + ai * HALF + m * 16) * DM;
#pragma unroll
                for (int bj = 0; bj < 2; ++bj) { const int col = col0 + bj * HALF;
                    const u32x4 xh = *(const u32x4*)(XH + ro + col);
                    const f32x4 a0 = acc[ai][bj][m][0], a1 = acc[ai][bj][m][1];
                    const f32x2_t x0 = up_h2(xh.x), x1 = up_h2(xh.y), x2 = up_h2(xh.z), x3 = up_h2(xh.w);
                    u32x4 w;
                    w.x = pk_h2(x0[0] * ALPHA + a0[0], x0[1] * ALPHA + a0[1]);
                    w.y = pk_h2(x1[0] * ALPHA + a0[2], x1[1] * ALPHA + a0[3]);
                    w.z = pk_h2(x2[0] * ALPHA + a1[0], x2[1] * ALPHA + a1[1]);
                    w.w = pk_h2(x3[0] * ALPHA + a1[2], x3[1] * ALPHA + a1[3]);
                    *(u32x4*)(Z + ro + col) = w; }
            }
    }
};
struct EpiGU {
    bf16_t* H; const float* roww;
    __device__ __forceinline__ void operator()(const f32x4 (&acc)[2][2][4][2], const Unit& u, int wr, int wc, int fr, int fq) const {
        const int row0 = u.pm * BM + wr * 64 + fr, col0 = u.pn * HALF + wc * 32 + 8 * fq;
#pragma unroll
        for (int ai = 0; ai < 2; ++ai)
#pragma unroll
            for (int m = 0; m < 4; ++m) {
                const int row = row0 + ai * HALF + m * 16; const float w = roww[row];
                unsigned pk[4];
#pragma unroll
                for (int n = 0; n < 2; ++n) { const f32x4 g = acc[ai][0][m][n], up = acc[ai][1][m][n]; float h[4];
#pragma unroll
                    for (int e = 0; e < 4; ++e) { const float s = __builtin_amdgcn_rcpf(1.f + __builtin_amdgcn_exp2f(-1.4426950408889634f * g[e])); h[e] = g[e] * s * up[e] * w; }
                    pk[2 * n] = cvt_pk_bf16(h[0], h[1]); pk[2 * n + 1] = cvt_pk_bf16(h[2], h[3]); }
                *(u32x4*)(H + (size_t)row * 512 + col0) = (u32x4){pk[0], pk[1], pk[2], pk[3]};
            }
    }
};
struct EpiDown {
    bf16_t* Y; const int* rowinfo;
    __device__ __forceinline__ void operator()(const f32x4 (&acc)[2][2][4][2], const Unit& u, int wr, int wc, int fr, int fq) const {
        const int row0 = u.pm * BM + wr * 64 + fr, col0 = u.pn * BM + wc * 32 + 8 * fq;
#pragma unroll
        for (int ai = 0; ai < 2; ++ai)
#pragma unroll
            for (int m = 0; m < 4; ++m) {
                const int row = row0 + ai * HALF + m * 16; const int d = rowinfo[row];
                if (d >= 0) {
#pragma unroll
                    for (int bj = 0; bj < 2; ++bj) { const f32x4 v0 = acc[ai][bj][m][0], v1 = acc[ai][bj][m][1];
                        u32x4 w; w.x = cvt_pk_bf16(v0[0], v0[1]); w.y = cvt_pk_bf16(v0[2], v0[3]); w.z = cvt_pk_bf16(v1[0], v1[1]); w.w = cvt_pk_bf16(v1[2], v1[3]);
                        *(u32x4*)(Y + (size_t)d * DM + col0 + bj * HALF) = w; }
                }
            }
    }
};
}

template <bool F16>
__device__ __forceinline__ void cvt_item(const float* W, int ldw, int col0, int k0, bf16_t* WT, int K, int n0, LAS float* scr, int lane, bool rperm = false) {
    const int c_ = lane & 31; const int sc_ = (rperm && c_ < 16 && ((c_ >> 2) == 1 || (c_ >> 2) == 2)) ? (c_ ^ 12) : c_;
#pragma unroll 8
    for (int i = 0; i < 32; ++i) { const int kk = 2 * i + (lane >> 5); scr[kk * 33 + c_] = W[(size_t)(k0 + kk) * ldw + col0 + sc_]; }
    asm volatile("s_waitcnt lgkmcnt(0)" ::: "memory");
    const int c = lane & 7;
#pragma unroll
    for (int j = 0; j < 4; ++j) { const int n = (lane >> 3) + 8 * j; const LAS float* s = scr + (8 * c) * 33 + n;
        u32x4 o;
        if (F16) { o.x = pk_h2(s[0 * 33], s[1 * 33]); o.y = pk_h2(s[2 * 33], s[3 * 33]); o.z = pk_h2(s[4 * 33], s[5 * 33]); o.w = pk_h2(s[6 * 33], s[7 * 33]); }
        else { o.x = cvt_pk_bf16(s[0 * 33], s[1 * 33]); o.y = cvt_pk_bf16(s[2 * 33], s[3 * 33]); o.z = cvt_pk_bf16(s[4 * 33], s[5 * 33]); o.w = cvt_pk_bf16(s[6 * 33], s[7 * 33]); }
        *(u32x4*)(WT + (size_t)(n0 + n) * K + k0 + 8 * c) = o; }
    asm volatile("s_waitcnt lgkmcnt(0)" ::: "memory");
}

__device__ __forceinline__ void prologue(const Params& P, LAS unsigned char* lds) {
    int tid = threadIdx.x; asm volatile("" : "+v"(tid)); const int wid = __builtin_amdgcn_readfirstlane(tid >> 6), lane = tid & 63;
    unsigned char* ws = P.ws;
    LAS float* scr = (LAS float*)(lds + wid * 16384);
    const int gw = blockIdx.x * 8 + wid, NGW = NG * 8;
    constexpr int N_A = 3072, N_B = 1024, N_C = 9216, N_D = 1024, N_E = 32768, N_F = 16384;
    for (int it = gw; it < N_A + N_B + N_C + N_D + N_E + N_F; it += NGW) {
        int gi = it;
        if (gi < N_A) { const int mat = gi / 1536, r = gi % 1536, kb = r / 96, nb = r % 96, n0 = 32 * nb; int col0 = n0;
            if (n0 < 2048) { const int base = (n0 >= 1024) ? 1024 : 0, nn = n0 & 1023, hh = nn >> 7, w = nn & 127; col0 = base + (w < 64 ? hh * 64 + w : 512 + hh * 64 + (w - 64)); }
            cvt_item<true>(P.in[2] + (size_t)mat * 1024 * 3072, 3072, col0, 64 * kb, (bf16_t*)(ws + W_DAIN) + (size_t)mat * 3072 * 1024, 1024, n0, scr, lane, n0 < 2048 && (n0 & 63) == 0); continue; }
        gi -= N_A;
        if (gi < N_B) { const int mat = gi / 512, r = gi % 512, kb = r / 32, nb = r % 32;
            cvt_item<false>(P.in[3] + (size_t)mat * 1024 * 1024, 1024, 32 * nb, 64 * kb, (bf16_t*)(ws + W_DAOUT) + (size_t)mat * 1024 * 1024, 1024, 32 * nb, scr, lane); continue; }
        gi -= N_B;
        if (gi < N_C) { const int mat = gi / 4608, r = gi % 4608, kb = r / 288, nb = r % 288;
            cvt_item<true>(P.in[9] + (size_t)mat * 1024 * 9216, 9216, 32 * nb, 64 * kb, (bf16_t*)(ws + W_DLIN) + (size_t)mat * 9216 * 1024, 1024, 32 * nb, scr, lane, ((32 * nb) % 3072) < 2048 && ((32 * nb) & 63) == 0); continue; }
        gi -= N_C;
        if (gi < N_D) { const int mat = gi / 512, r = gi % 512, kb = r / 32, nb = r % 32;
            cvt_item<false>(P.in[10] + (size_t)mat * 1024 * 1024, 1024, 32 * nb, 64 * kb, (bf16_t*)(ws + W_DLOUT) + (size_t)mat * 1024 * 1024, 1024, 32 * nb, scr, lane); continue; }
        gi -= N_D;
        if (gi < N_E) { const int mat = gi / 512, r = gi % 512, kb = r / 32, nb = r % 32, n0 = 32 * nb, pn = n0 >> 8, w = n0 & 255;
            const float* src = ((w < 128) ? P.in[17] : P.in[18]) + (size_t)mat * 1024 * 512;
            cvt_item<true>(src, 512, pn * 128 + (w & 127), 64 * kb, (bf16_t*)(ws + W_GU) + (size_t)mat * 1024 * 1024, 1024, n0, scr, lane); continue; }
        gi -= N_E;
        { const int mat = gi / 256, r = gi % 256, kb = r / 32, nb = r % 32;
            cvt_item<false>(P.in[19] + (size_t)mat * 512 * 1024, 1024, 32 * nb, 64 * kb, (bf16_t*)(ws + W_DN) + (size_t)mat * 1024 * 512, 512, 32 * nb, scr, lane); }
    }
    for (int i = blockIdx.x * 512 + tid; i < 8192 * 8; i += NG * 512) {
        const int pos = i >> 3, j = i & 7;
        const float inv = (float)exp(-(double)j * 0.125 * 13.122363377404328);
        const float ang = (float)pos * inv;
        const double rev = (double)ang * 0.15915494309189535; const float fr = (float)(rev - rint(rev));
        float* tp = (float*)(ws + WS_ROPE) + (size_t)i * 2;
        tp[0] = __builtin_amdgcn_cosf(fr); tp[1] = __builtin_amdgcn_sinf(fr);
    }
    unsigned short* XH0 = (unsigned short*)P.out + (size_t)T * DM;
    for (size_t i = (size_t)blockIdx.x * 512 + tid; i < (size_t)T * DM / 8; i += (size_t)NG * 512) {
        const size_t e = i * 8; const float* src = (e < (size_t)TP * DM) ? P.in[0] + e : P.in[1] + (e - (size_t)TP * DM);
        const f32x4 a = *(const f32x4*)src, b = *(const f32x4*)(src + 4);
        *(u32x4*)(XH0 + e) = (u32x4){pk_h2(a[0], a[1]), pk_h2(a[2], a[3]), pk_h2(b[0], b[1]), pk_h2(b[2], b[3])};
    }
}

template <int NTK>
__device__ __forceinline__ void ln_rows(f32x4 (&v)[NTK][4], const float* g, const float* b, float* Xout, unsigned short* XH, const int (&tok)[NTK], int lane) {
    float s[NTK], s2[NTK];
#pragma unroll
    for (int t = 0; t < NTK; ++t) { s[t] = 0.f;
#pragma unroll
        for (int j = 0; j < 4; ++j) s[t] += (v[t][j][0] + v[t][j][1]) + (v[t][j][2] + v[t][j][3]); }
#pragma unroll
    for (int t = 0; t < NTK; ++t) s[t] = wave_allsum(s[t]);
#pragma unroll
    for (int t = 0; t < NTK; ++t) { const float mean = s[t] * (1.f / DM); s2[t] = 0.f;
#pragma unroll
        for (int j = 0; j < 4; ++j) { v[t][j] = v[t][j] - mean; s2[t] += (v[t][j][0] * v[t][j][0] + v[t][j][1] * v[t][j][1]) + (v[t][j][2] * v[t][j][2] + v[t][j][3] * v[t][j][3]); } }
#pragma unroll
    for (int t = 0; t < NTK; ++t) s2[t] = wave_allsum(s2[t]);
#pragma unroll
    for (int j = 0; j < 4; ++j) { const f32x4 gg = *(const f32x4*)(g + 256 * j + 4 * lane), bb = *(const f32x4*)(b + 256 * j + 4 * lane);
#pragma unroll
        for (int t = 0; t < NTK; ++t) { const float rstd = 1.0f / sqrtf(s2[t] * (1.f / DM) + LN_EPS);
            v[t][j] = v[t][j] * rstd * gg + bb;
            if (Xout) *(f32x4*)(Xout + (size_t)tok[t] * DM + 256 * j + 4 * lane) = v[t][j];
            else *(u32x2*)(XH + (size_t)tok[t] * DM + 256 * j + 4 * lane) = (u32x2){pk_h2(v[t][j][0], v[t][j][1]), pk_h2(v[t][j][2], v[t][j][3])}; } }
}

__device__ __forceinline__ void phase_ln1_router(const Params& P, int layer, LAS unsigned char* lds) {
    constexpr int NTK = 2;
    int tid = threadIdx.x; asm volatile("" : "+v"(tid)); const int wid = __builtin_amdgcn_readfirstlane(tid >> 6), lane_ = tid & 63;
    unsigned char* ws = P.ws; const unsigned short* Z = (const unsigned short*)P.out; unsigned short* XH = (layer == 3) ? (unsigned short*)(ws + WS_XB) : (unsigned short*)P.out + (size_t)T * DM;
    LAS int* lcnt = (LAS int*)(lds + LDS_TAB + 512);
    if (tid < 16) lcnt[tid] = 0;
    const float* g = P.in[11] + layer * DM; const float* b = P.in[12] + layer * DM;
    const float* Wg = P.in[15] + (size_t)layer * DM * 4; const float* We = P.in[16] + (size_t)layer * DM * 16;
    LAS f32x4* W2 = (LAS f32x4*)lds;
    for (int item = tid; item < 5 * 1024; item += 512) { const int plane = item >> 10, k = item & 1023;
        const f32x4 w = (plane == 0) ? *(const f32x4*)(Wg + 4 * k) : *(const f32x4*)(We + 16 * k + 4 * (plane - 1));
        W2[(((k >> 8) * 4 + (k & 3)) * 5 + plane) * 64 + ((k & 255) >> 2)] = w; }
    __syncthreads();
    int* tokinfo = (int*)(ws + WS_TOK);
    for (int it = 0; it < TPB / 8; it += NTK) {
        int lane = lane_; asm volatile("" : "+v"(lane));
        int tok[NTK]; f32x4 v[NTK][4];
#pragma unroll
        for (int t = 0; t < NTK; ++t) { tok[t] = blockIdx.x * TPB + (it + t) * 8 + wid;
#pragma unroll
            for (int j = 0; j < 4; ++j) { const u32x2 z = *(const u32x2*)(Z + (size_t)tok[t] * DM + 256 * j + 4 * lane);
                const f32x2_t z0 = up_h2(z.x), z1 = up_h2(z.y); v[t][j] = (f32x4){z0[0], z0[1], z1[0], z1[1]}; } }
        ln_rows<NTK>(v, g, b, nullptr, XH, tok, lane);
        float lg[NTK][4];
#pragma unroll
        for (int t = 0; t < NTK; ++t) { lg[t][0] = 0.f; lg[t][1] = 0.f; lg[t][2] = 0.f; lg[t][3] = 0.f; }
#pragma unroll
        for (int j = 0; j < 4; ++j)
#pragma unroll
            for (int e = 0; e < 4; ++e) { const f32x4 w = W2[((j * 4 + e) * 5) * 64 + lane];
#pragma unroll
                for (int t = 0; t < NTK; ++t) { lg[t][0] += v[t][j][e] * w[0]; lg[t][1] += v[t][j][e] * w[1]; lg[t][2] += v[t][j][e] * w[2]; lg[t][3] += v[t][j][e] * w[3]; } }
#pragma unroll
        for (int t = 0; t < NTK; ++t)
#pragma unroll
            for (int q = 0; q < 4; ++q) lg[t][q] = wave_allsum(lg[t][q]);
        int gs[NTK]; float gw[NTK]; float el[NTK][4];
#pragma unroll
        for (int t = 0; t < NTK; ++t) { int gsel = 0; float gm = lg[t][0];
#pragma unroll
            for (int q = 1; q < 4; ++q) if (lg[t][q] > gm) { gm = lg[t][q]; gsel = q; }
            float den = 0.f;
#pragma unroll
            for (int q = 0; q < 4; ++q) den += __expf(lg[t][q] - gm);
            gw[t] = 1.f / den; gs[t] = __builtin_amdgcn_readfirstlane(gsel);
            el[t][0] = 0.f; el[t][1] = 0.f; el[t][2] = 0.f; el[t][3] = 0.f; }
#pragma unroll
        for (int j = 0; j < 4; ++j)
#pragma unroll
            for (int e = 0; e < 4; ++e) { const LAS f32x4* wr_ = W2 + ((j * 4 + e) * 5 + 1) * 64 + lane;
#pragma unroll
                for (int t = 0; t < NTK; ++t) { const f32x4 w = wr_[gs[t] * 64];
                    el[t][0] += v[t][j][e] * w[0]; el[t][1] += v[t][j][e] * w[1]; el[t][2] += v[t][j][e] * w[2]; el[t][3] += v[t][j][e] * w[3]; } }
#pragma unroll
        for (int t = 0; t < NTK; ++t)
#pragma unroll
            for (int q = 0; q < 4; ++q) el[t][q] = wave_allsum(el[t][q]);
#pragma unroll
        for (int t = 0; t < NTK; ++t) {
            int i1 = 0; float v1 = el[t][0];
#pragma unroll
            for (int q = 1; q < 4; ++q) if (el[t][q] > v1) { v1 = el[t][q]; i1 = q; }
            int i2 = -1; float v2 = -3.0e38f;
#pragma unroll
            for (int q = 0; q < 4; ++q) if (q != i1 && el[t][q] > v2) { v2 = el[t][q]; i2 = q; }
            const float w1 = gw[t] / (1.f + __expf(v2 - v1)); const float w2 = gw[t] - w1;
            if (lane == 0) {
                const int b1 = gs[t] * 4 + i1, b2 = gs[t] * 4 + i2;
                const int s1 = atomicAdd((int*)(lcnt + b1), 1); const int s2 = atomicAdd((int*)(lcnt + b2), 1);
                int* ti = tokinfo + (size_t)tok[t] * 8;
                ti[0] = b1; ti[1] = s1; ti[2] = __float_as_int(w1); ti[3] = b2; ti[4] = s2; ti[5] = __float_as_int(w2);
            }
        }
    }
    __syncthreads();
    if (tid < 16) ((int*)(ws + WS_CNT))[blockIdx.x * 16 + tid] = lcnt[tid];
}

__device__ __forceinline__ void phase_gather(const Params& P, int layer, LAS unsigned char* lds) {
    constexpr int NTK = 4;
    int tid = threadIdx.x; asm volatile("" : "+v"(tid)); const int wid = __builtin_amdgcn_readfirstlane(tid >> 6), lane_ = tid & 63;
    unsigned char* ws = P.ws;
    LAS int* off = (LAS int*)(lds + LDS_TAB);
    LAS int* lbase = (LAS int*)(lds + LDS_TAB + 128);
    LAS int* ltot = (LAS int*)(lds + LDS_TAB + 256);
    const int* cnt = (const int*)(ws + WS_CNT);
    int* rowinfo = (int*)(ws + WS_ROWI); float* roww = (float*)(ws + WS_ROWW);
    if (tid < 256) { const int b = tid & 15, part = tid >> 4; int tot = 0, mine = 0;
        for (int k = 0; k < 16; ++k) { const int blk = part * 16 + k; const int c = cnt[blk * 16 + b]; mine += (blk < (int)blockIdx.x) ? c : 0; tot += c; }
        LAS int* pt = (LAS int*)(lds + 0); pt[tid] = tot; pt[256 + tid] = mine; }
    __syncthreads();
    if (tid < 16) { const LAS int* pt = (const LAS int*)(lds + 0); int tot = 0, mine = 0;
        for (int k = 0; k < 16; ++k) { tot += pt[k * 16 + tid]; mine += pt[256 + k * 16 + tid]; }
        ltot[tid] = tot; lbase[tid] = mine; }
    __syncthreads();
    if (tid == 0) { int o = 0; for (int b = 0; b < 16; ++b) { off[b] = o; o += (ltot[b] + 255) & ~255; } off[16] = o; }
    __syncthreads();
    if (blockIdx.x < 16) { const int b = blockIdx.x; for (int r = off[b] + ltot[b] + tid; r < off[b + 1]; r += 512) { rowinfo[r] = -1; roww[r] = 0.f; } }
    const int* tokinfo = (const int*)(ws + WS_TOK);
    for (int it = 0; it < TPB / 8; it += NTK) {
        int lane = lane_; asm volatile("" : "+v"(lane));
        int tok[NTK], r1[NTK], r2[NTK]; int w1[NTK], w2[NTK];
#pragma unroll
        for (int t = 0; t < NTK; ++t) { tok[t] = blockIdx.x * TPB + (it + t) * 8 + wid;
            const int* ti = tokinfo + (size_t)tok[t] * 8;
            const int b1 = ti[0], s1 = ti[1], b2 = ti[3], s2 = ti[4]; w1[t] = ti[2]; w2[t] = ti[5];
            r1[t] = off[b1] + lbase[b1] + s1; r2[t] = off[b2] + lbase[b2] + s2; }
#pragma unroll
        for (int t = 0; t < NTK; ++t) {
            if (lane == 0) { rowinfo[r1[t]] = tok[t] * 2; roww[r1[t]] = __int_as_float(w1[t]); rowinfo[r2[t]] = tok[t] * 2 + 1; roww[r2[t]] = __int_as_float(w2[t]); } }
    }
}

__device__ __forceinline__ void phase_ln2(const Params& P, int layer) {
    constexpr int NTK = 4;
    int tid = threadIdx.x; asm volatile("" : "+v"(tid)); const int wid = __builtin_amdgcn_readfirstlane(tid >> 6), lane_ = tid & 63;
    unsigned char* ws = P.ws; float* Xout = (layer == 3) ? P.out : nullptr; unsigned short* XH = (layer == 3) ? (unsigned short*)(ws + WS_XB) : (unsigned short*)P.out + (size_t)T * DM; const bf16_t* Y = (const bf16_t*)(ws + WS_BIG);
    const float* g = P.in[13] + layer * DM; const float* b = P.in[14] + layer * DM;
    for (int it = 0; it < TPB / 8; it += NTK) {
        int lane = lane_; asm volatile("" : "+v"(lane));
        int tok[NTK]; f32x4 v[NTK][4];
#pragma unroll
        for (int t = 0; t < NTK; ++t) { tok[t] = blockIdx.x * TPB + (it + t) * 8 + wid;
#pragma unroll
            for (int j = 0; j < 4; ++j) { f32x4 x;
                { const u32x2 xh = *(const u32x2*)(XH + (size_t)tok[t] * DM + 256 * j + 4 * lane); const f32x2_t h0 = up_h2(xh.x), h1 = up_h2(xh.y); x = (f32x4){h0[0], h0[1], h1[0], h1[1]}; }
                const u32x2 y0 = *(const u32x2*)(Y + (size_t)(2 * tok[t]) * DM + 256 * j + 4 * lane), y1 = *(const u32x2*)(Y + (size_t)(2 * tok[t] + 1) * DM + 256 * j + 4 * lane);
                f32x4 f0 = {__uint_as_float(y0.x << 16), __uint_as_float(y0.x & 0xffff0000u), __uint_as_float(y0.y << 16), __uint_as_float(y0.y & 0xffff0000u)};
                f32x4 f1 = {__uint_as_float(y1.x << 16), __uint_as_float(y1.x & 0xffff0000u), __uint_as_float(y1.y << 16), __uint_as_float(y1.y & 0xffff0000u)};
                v[t][j] = x * ALPHA + f0 + f1; } }
        ln_rows<NTK>(v, g, b, Xout, XH, tok, lane);
    }
}

#define KSWZ(row, colB) ((row) * 256 + ((colB) ^ (((row) & 15) << 4)))
__device__ __forceinline__ int v_rd_base(int lane) { return ((lane & 3) << 3) | (((lane >> 2) & 3) << 6) | (((lane >> 4) & 1) << 5) | (((lane >> 5) & 1) << 8); }
#define TR_READ(dst, vb, OFF) asm volatile("ds_read_b64_tr_b16 %0, %1 offset:%c2" : "=&v"(dst) : "v"(vb), "i"(OFF) : "memory")
#define PKV(L, H) (bf16x8){L[0], L[1], L[2], L[3], H[0], H[1], H[2], H[3]}
#define PK4(P, BASE, OUT) do { u32x4 w_ = {cvt_pk_bf16(P[BASE + 0], P[BASE + 1]), cvt_pk_bf16(P[BASE + 2], P[BASE + 3]), \
    cvt_pk_bf16(P[BASE + 4], P[BASE + 5]), cvt_pk_bf16(P[BASE + 6], P[BASE + 7])}; OUT = __builtin_bit_cast(bf16x8, w_); } while (0)
constexpr float THR2 = 11.5f;

__device__ __forceinline__ void softmax_tile(f32x16& p0, f32x16& p1, float& m_reg, float& l_reg, float& alpha, bf16x8& a0, bf16x8& a1, bf16x8& a2, bf16x8& a3) {
    float pmax = p0[0];
#pragma unroll
    for (int r = 1; r < 16; ++r) pmax = fmaxf(pmax, p0[r]);
#pragma unroll
    for (int r = 0; r < 16; ++r) pmax = fmaxf(pmax, p1[r]);
    { auto rr = __builtin_amdgcn_permlane32_swap(__float_as_uint(pmax), __float_as_uint(pmax), false, false); pmax = fmaxf(__uint_as_float(rr[0]), __uint_as_float(rr[1])); }
    if (__builtin_expect(__all(pmax - m_reg <= THR2), 1)) { alpha = 1.f; }
    else { const float mn = fmaxf(m_reg, pmax); alpha = __builtin_amdgcn_exp2f(m_reg - mn); m_reg = mn; }
#pragma unroll
    for (int r = 0; r < 16; ++r) { p0[r] = __builtin_amdgcn_exp2f(p0[r] - m_reg); p1[r] = __builtin_amdgcn_exp2f(p1[r] - m_reg); }
    float ps = 0.f;
#pragma unroll
    for (int r = 0; r < 16; ++r) ps += p0[r] + p1[r];
    { auto rr = __builtin_amdgcn_permlane32_swap(__float_as_uint(ps), __float_as_uint(ps), false, false); ps = __uint_as_float(rr[0]) + __uint_as_float(rr[1]); }
    l_reg = l_reg * alpha + ps;
    PK4(p0, 0, a0); PK4(p0, 8, a1); PK4(p1, 0, a2); PK4(p1, 8, a3);
}

typedef float f32x2 __attribute__((ext_vector_type(2)));
template <bool FIRST>
__device__ __forceinline__ void partialSM(f32x16& p0, f32x16& p1, float& mhat, f32x16& negm, float& alpha) {
    float pmax = p0[0];
#pragma unroll
    for (int r = 1; r < 16; ++r) pmax = fmaxf(pmax, p0[r]);
#pragma unroll
    for (int r = 0; r < 16; ++r) pmax = fmaxf(pmax, p1[r]);
    { auto rr = __builtin_amdgcn_permlane32_swap(__float_as_uint(pmax), __float_as_uint(pmax), false, false); pmax = fmaxf(__uint_as_float(rr[0]), __uint_as_float(rr[1])); }
    alpha = 1.f;
    if (FIRST) {
        const float dl = pmax; mhat += dl;
#pragma unroll
        for (int r = 0; r < 16; ++r) { p0[r] = __builtin_amdgcn_exp2f(p0[r] - dl); p1[r] -= dl; }
#pragma unroll
        for (int r = 0; r < 16; ++r) negm[r] = -mhat;
        asm volatile("" : "+v"(negm));
        alpha = __builtin_amdgcn_exp2f(-dl);
    } else {
#pragma unroll
        for (int r = 0; r < 16; ++r) p0[r] = __builtin_amdgcn_exp2f(p0[r]);
        if (__builtin_expect(__any(pmax > THR2), 0)) {
            const float dl = fmaxf(pmax, 0.f); mhat += dl; alpha = __builtin_amdgcn_exp2f(-dl);
#pragma unroll
            for (int r = 0; r < 16; ++r) { p0[r] *= alpha; p1[r] -= dl; }
#pragma unroll
            for (int r = 0; r < 16; ++r) negm[r] = -mhat;
            asm volatile("" : "+v"(negm));
        }
    }
}
__device__ __forceinline__ void finishSM(f32x16& p0, f32x16& p1, float alpha, float& l_reg, bf16x8& a0, bf16x8& a1, bf16x8& a2, bf16x8& a3) {
#pragma unroll
    for (int r = 0; r < 16; ++r) p1[r] = __builtin_amdgcn_exp2f(p1[r]);
    float sa = p0[0], sb = p1[0];
#pragma unroll
    for (int r = 1; r < 16; ++r) { sa += p0[r]; asm("" : "+v"(sa)); sb += p1[r]; asm("" : "+v"(sb)); }
    float ps = sa + sb;
    { auto rr = __builtin_amdgcn_permlane32_swap(__float_as_uint(ps), __float_as_uint(ps), false, false); ps = __uint_as_float(rr[0]) + __uint_as_float(rr[1]); }
    l_reg = l_reg * alpha + ps;
    PK4(p0, 0, a0); PK4(p0, 8, a1); PK4(p1, 0, a2); PK4(p1, 8, a3);
}

__device__ __forceinline__ void da_unit(bf16_t* proj, int tok0, int seq, int h, int qb, int ntok0, int nh, int nqb, bool first, bool has_next, bf16x8 (&qn)[4],
                                        float lam, const float* subg, float osc, LAS unsigned char* lds, unsigned lds0) {
    constexpr int LDP = 3072;
    int tid = threadIdx.x; asm volatile("" : "+v"(tid));
    const int wid = __builtin_amdgcn_readfirstlane(tid >> 6), lane = tid & 63, r32 = lane & 31, hi = lane >> 5;
    const int rg = wid & 3, map = wid >> 2;
    const bf16_t* Qw = proj + (size_t)(tok0 + qb * 128 + rg * 32 + r32) * LDP + h * 128 + map * 64 + hi * 8;
    const bf16_t* Kh = proj + (size_t)tok0 * LDP + 1024 + h * 128;
    const bf16_t* Vh = proj + (size_t)tok0 * LDP + 2048 + h * 128;
    int koff[2], voff[2];
#pragma unroll
    for (int i = 0; i < 2; ++i) { const int L = (i * 8 + wid) * 1024 + lane * 16;
        { const int row = L >> 8, pc = L & 255, lc = pc ^ ((row & 15) << 4); koff[i] = row * LDP + (lc >> 1); }
        { const int sub = L >> 9, k = (sub >> 2) * 8 + ((L & 511) >> 6), col = (sub & 3) * 32 + ((L & 63) >> 1); voff[i] = k * LDP + col; } }
    LAS float* wsf = (LAS float*)(lds + 98304) + wid * 64;
#define DA_DMAK(t, boff) do { const size_t tb_ = (size_t)(t) * 64 * LDP; _Pragma("unroll") for (int i_ = 0; i_ < 2; ++i_) \
        glds16(Kh + tb_ + koff[i_], (unsigned)__builtin_amdgcn_readfirstlane(lds0 + (boff) + (i_ * 8 + wid) * 1024)); } while (0)
#define DA_DMAV(t, boff) do { const size_t tb_ = (size_t)(t) * 64 * LDP; _Pragma("unroll") for (int i_ = 0; i_ < 2; ++i_) \
        glds16(Vh + tb_ + voff[i_], (unsigned)__builtin_amdgcn_readfirstlane(lds0 + 49152 + (boff) + (i_ * 8 + wid) * 1024)); } while (0)
#define DA_WAITBAR(n) do { if ((n) == 4) asm volatile("s_waitcnt vmcnt(4) lgkmcnt(0)\n\ts_barrier" ::: "memory"); \
        else if ((n) == 2) asm volatile("s_waitcnt vmcnt(2) lgkmcnt(0)\n\ts_barrier" ::: "memory"); else WAIT_BAR(); } while (0)
    if (first) {
#pragma unroll
        for (int d0 = 0; d0 < 4; ++d0) asm volatile("global_load_dwordx4 %0, %1, off" : "=&v"(qn[d0]) : "v"(Qw + d0 * 16) : "memory");
        DA_DMAK(0, 0); DA_DMAK(1, 16384); DA_DMAV(0, 0); DA_DMAK(2, 32768); DA_DMAV(1, 16384);
    }
    float m1 = 0.f, l1 = 0.f;
    f32x16 negm = f32x16{}; asm volatile("" : "+v"(negm));
    f32x16 o1[4];
#pragma unroll
    for (int d = 0; d < 4; ++d) o1[d] = f32x16{};
    const int NT = seq / 64;
    const int vb0 = (int)lds0 + 49152 + v_rd_base(lane);
    const int kcb = map * 128 + hi * 16;
#define DA_QKT(P0, P1, boff) do { const LAS unsigned char* Kt_ = lds + (boff); bf16x8 kf_[4]; \
          \
        kf_[0] = *(const LAS bf16x8*)(Kt_ + KSWZ(r32, kcb)); kf_[1] = *(const LAS bf16x8*)(Kt_ + KSWZ(32 + r32, kcb)); \
        kf_[2] = *(const LAS bf16x8*)(Kt_ + KSWZ(r32, kcb + 32)); kf_[3] = *(const LAS bf16x8*)(Kt_ + KSWZ(32 + r32, kcb + 32)); SBAR(); \
        P0 = __builtin_amdgcn_mfma_f32_32x32x16_bf16(kf_[0], qr[0], negm, 0, 0, 0); P1 = __builtin_amdgcn_mfma_f32_32x32x16_bf16(kf_[1], qr[0], negm, 0, 0, 0); \
        P0 = __builtin_amdgcn_mfma_f32_32x32x16_bf16(kf_[2], qr[1], P0, 0, 0, 0); P1 = __builtin_amdgcn_mfma_f32_32x32x16_bf16(kf_[3], qr[1], P1, 0, 0, 0); \
        kf_[0] = *(const LAS bf16x8*)(Kt_ + KSWZ(r32, kcb + 64)); kf_[1] = *(const LAS bf16x8*)(Kt_ + KSWZ(32 + r32, kcb + 64)); \
        kf_[2] = *(const LAS bf16x8*)(Kt_ + KSWZ(r32, kcb + 96)); kf_[3] = *(const LAS bf16x8*)(Kt_ + KSWZ(32 + r32, kcb + 96)); SBAR(); \
        P0 = __builtin_amdgcn_mfma_f32_32x32x16_bf16(kf_[0], qr[2], P0, 0, 0, 0); P1 = __builtin_amdgcn_mfma_f32_32x32x16_bf16(kf_[1], qr[2], P1, 0, 0, 0); \
        P0 = __builtin_amdgcn_mfma_f32_32x32x16_bf16(kf_[2], qr[3], P0, 0, 0, 0); P1 = __builtin_amdgcn_mfma_f32_32x32x16_bf16(kf_[3], qr[3], P1, 0, 0, 0); } while (0)
#define DA_PV(boff) do { const int vb = vb0 + (boff); _Pragma("unroll") for (int d0 = 0; d0 < 4; ++d0) { \
            s16x4 l0_, h0_, l1_, h1_, l2_, h2_, l3_, h3_; \
            TR_READ(l0_, vb, d0 * 512 + 0 * 4096); TR_READ(h0_, vb, d0 * 512 + 0 * 4096 + 2048); \
            TR_READ(l1_, vb, d0 * 512 + 1 * 4096); TR_READ(h1_, vb, d0 * 512 + 1 * 4096 + 2048); \
            TR_READ(l2_, vb, d0 * 512 + 2 * 4096); TR_READ(h2_, vb, d0 * 512 + 2 * 4096 + 2048); \
            TR_READ(l3_, vb, d0 * 512 + 3 * 4096); TR_READ(h3_, vb, d0 * 512 + 3 * 4096 + 2048); \
            asm volatile("s_waitcnt lgkmcnt(0)" ::: "memory"); SBAR(); \
            o1[d0] = __builtin_amdgcn_mfma_f32_32x32x16_bf16(pa0, PKV(l0_, h0_), o1[d0], 0, 0, 0); \
            o1[d0] = __builtin_amdgcn_mfma_f32_32x32x16_bf16(pa1, PKV(l1_, h1_), o1[d0], 0, 0, 0); \
            o1[d0] = __builtin_amdgcn_mfma_f32_32x32x16_bf16(pa2, PKV(l2_, h2_), o1[d0], 0, 0, 0); \
            o1[d0] = __builtin_amdgcn_mfma_f32_32x32x16_bf16(pa3, PKV(l3_, h3_), o1[d0], 0, 0, 0); } } while (0)
#define DA_RESC(a) do { if (__any((a) < 1.f)) { if (hi == 0) wsf[r32] = (a); asm volatile("s_waitcnt lgkmcnt(0)" ::: "memory"); \
        _Pragma("unroll") for (int d = 0; d < 4; ++d) _Pragma("unroll") for (int r = 0; r < 16; ++r) o1[d][r] *= wsf[crow(r, hi)]; } } while (0)
    f32x16 pA0, pA1, pB0, pB1; float alA, alB; bf16x8 pa0, pa1, pa2, pa3;
    asm volatile("s_waitcnt vmcnt(8)\n\ts_barrier" : "+v"(qn[0]), "+v"(qn[1]), "+v"(qn[2]), "+v"(qn[3]) :: "memory");
    bf16x8 qr[4];
#pragma unroll
    for (int d0 = 0; d0 < 4; ++d0) qr[d0] = qn[d0];
    DA_QKT(pA0, pA1, 0); partialSM<true>(pA0, pA1, m1, negm, alA); alA = 1.f;
    int cur = 0, nxt = 16384, nn = 32768;
    for (int j = 0; j < NT; j += 2) {
        DA_WAITBAR(2 * (j + 2 < NT) + 2 * (j + 1 < NT));
        if (j + 3 < NT) DA_DMAK(j + 3, cur);
        if (j + 2 < NT) DA_DMAV(j + 2, nn);
        SBAR(); DA_QKT(pB0, pB1, nxt);
        finishSM(pA0, pA1, alA, l1, pa0, pa1, pa2, pa3); SBAR();
        DA_PV(cur); partialSM<false>(pB0, pB1, m1, negm, alB);
        DA_RESC(alB);
        { const int t_ = cur; cur = nxt; nxt = nn; nn = t_; }
        DA_WAITBAR(2 * (j + 3 < NT) + 2 * (j + 2 < NT));
        if (j + 4 < NT) DA_DMAK(j + 4, cur);
        if (j + 3 < NT) DA_DMAV(j + 3, nn);
        SBAR(); if (j + 2 < NT) DA_QKT(pA0, pA1, nxt);
        finishSM(pB0, pB1, alB, l1, pa0, pa1, pa2, pa3); SBAR();
        DA_PV(cur); if (j + 2 < NT) { partialSM<false>(pA0, pA1, m1, negm, alA); DA_RESC(alA); }
        { const int t_ = cur; cur = nxt; nxt = nn; nn = t_; }
    }
#undef DA_WAITBAR
#undef DA_QKT
#undef DA_PV
#undef DA_RESC
    WAIT_BAR();
    if (has_next) {
        const bf16_t* nQw = proj + (size_t)(ntok0 + nqb * 128 + rg * 32 + r32) * LDP + nh * 128 + map * 64 + hi * 8;
        Kh = proj + (size_t)ntok0 * LDP + 1024 + nh * 128; Vh = proj + (size_t)ntok0 * LDP + 2048 + nh * 128;
#pragma unroll
        for (int d0 = 0; d0 < 4; ++d0) asm volatile("global_load_dwordx4 %0, %1, off" : "=&v"(qn[d0]) : "v"(nQw + d0 * 16) : "memory");
        DA_DMAK(0, 0); DA_DMAK(1, 16384); DA_DMAV(0, 0); DA_DMAK(2, 32768); DA_DMAV(1, 16384);
    }
#undef DA_DMAK
#undef DA_DMAV
    if (hi == 0) wsf[r32] = (map == 0 ? 1.f : lam) / l1;
    asm volatile("s_waitcnt lgkmcnt(0)" ::: "memory");
#pragma unroll
    for (int r = 0; r < 16; ++r) { const float ra = wsf[crow(r, hi)];
#pragma unroll
        for (int d = 0; d < 4; ++d) o1[d][r] *= ra; }
    LAS unsigned* xch = (LAS unsigned*)(lds + (rg < 2 ? 81920 + rg * 8192 : 100352 + (rg - 2) * 8192));
    if (map == 1) {
#pragma unroll
        for (int d = 0; d < 4; ++d)
#pragma unroll
            for (int r = 0; r < 16; r += 2) xch[(d * 8 + (r >> 1)) * 64 + lane] = cvt_pk_bf16(o1[d][r], o1[d][r + 1]);
    }
    asm volatile("s_waitcnt lgkmcnt(0)\n\ts_barrier" ::: "memory");
    if (map == 0) {
        float ss[16];
#pragma unroll
        for (int d = 0; d < 4; ++d)
#pragma unroll
            for (int r = 0; r < 16; r += 2) { const unsigned w = xch[(d * 8 + (r >> 1)) * 64 + lane];
                o1[d][r] -= __uint_as_float(w << 16); o1[d][r + 1] -= __uint_as_float(w & 0xffff0000u); }
#pragma unroll
        for (int r = 0; r < 16; ++r) { float s = 0.f;
#pragma unroll
            for (int d = 0; d < 4; ++d) s += o1[d][r] * o1[d][r];
            ss[r] = s; }
#pragma unroll
        for (int r = 0; r < 16; ++r) {
            float v_ = ss[r];
            v_ += __builtin_bit_cast(float, __builtin_amdgcn_update_dpp(0, __builtin_bit_cast(int, v_), 0xB1, 0xF, 0xF, true));
            v_ += __builtin_bit_cast(float, __builtin_amdgcn_update_dpp(0, __builtin_bit_cast(int, v_), 0x4E, 0xF, 0xF, true));
            v_ += __builtin_bit_cast(float, __builtin_amdgcn_update_dpp(0, __builtin_bit_cast(int, v_), 0x141, 0xF, 0xF, true));
            v_ += __builtin_bit_cast(float, __builtin_amdgcn_update_dpp(0, __builtin_bit_cast(int, v_), 0x140, 0xF, 0xF, true));
            v_ += __builtin_bit_cast(float, __builtin_amdgcn_ds_bpermute((lane ^ 16) << 2, __builtin_bit_cast(int, v_)));
            ss[r] = osc / sqrtf(v_ * (1.f / 128.f) + LN_EPS); }
        float gsub[4];
#pragma unroll
        for (int d = 0; d < 4; ++d) gsub[d] = subg[d * 32 + r32];
        asm volatile("s_waitcnt lgkmcnt(0)" ::: "memory");
        LAS bf16_t* stg = (LAS bf16_t*)xch;
#pragma unroll
        for (int r = 0; r < 16; ++r) { const int orow = crow(r, hi);
#pragma unroll
            for (int d = 0; d < 4; ++d) stg[orow * 128 + d * 32 + r32] = (bf16_t)(cvt_pk_bf16(o1[d][r] * ss[r] * gsub[d], 0.f) & 0xffffu); }
        asm volatile("s_waitcnt lgkmcnt(0)" ::: "memory");
        bf16_t* Ow = proj + (size_t)(tok0 + qb * 128 + rg * 32) * LDP + h * 128;
#pragma unroll
        for (int i = 0; i < 8; ++i) { const int p = i * 64 + lane, row = p >> 4, ch = p & 15;
            const u32x4 v = *(const LAS u32x4*)(stg + row * 128 + ch * 8); *(u32x4*)(Ow + (size_t)row * LDP + ch * 8) = v; }
    }
    asm volatile("s_waitcnt lgkmcnt(0)\n\ts_barrier" ::: "memory");
}

#define DL_VOFF(KB0, c_, half_, d0_) (((2 * (KB0) + (c_)) >> 2) * 8192 + ((((2 * (KB0) + (c_)) & 3) * 2 + (half_)) * 2 + (d0_)) * 512)
#define DL_PV(KB0) do { _Pragma("unroll") for (int d0 = 0; d0 < 2; ++d0) { \
        _Pragma("unroll") for (int cq = 0; cq < 8; cq += 4) { s16x4 la_, ha_, lb_, hb_, lc_, hc_, ld_, hd_;        \
            TR_READ(la_, vb, DL_VOFF(KB0, cq, 0, d0)); TR_READ(ha_, vb, DL_VOFF(KB0, cq, 1, d0)); TR_READ(lb_, vb, DL_VOFF(KB0, cq + 1, 0, d0)); TR_READ(hb_, vb, DL_VOFF(KB0, cq + 1, 1, d0)); \
            TR_READ(lc_, vb, DL_VOFF(KB0, cq + 2, 0, d0)); TR_READ(hc_, vb, DL_VOFF(KB0, cq + 2, 1, d0)); TR_READ(ld_, vb, DL_VOFF(KB0, cq + 3, 0, d0)); TR_READ(hd_, vb, DL_VOFF(KB0, cq + 3, 1, d0)); \
            asm volatile("s_waitcnt lgkmcnt(0)" ::: "memory"); SBAR(); \
            o[d0] = __builtin_amdgcn_mfma_f32_32x32x16_bf16(pa[cq], PKV(la_, ha_), o[d0], 0, 0, 0); o[d0] = __builtin_amdgcn_mfma_f32_32x32x16_bf16(pa[cq + 1], PKV(lb_, hb_), o[d0], 0, 0, 0); \
            o[d0] = __builtin_amdgcn_mfma_f32_32x32x16_bf16(pa[cq + 2], PKV(lc_, hc_), o[d0], 0, 0, 0); o[d0] = __builtin_amdgcn_mfma_f32_32x32x16_bf16(pa[cq + 3], PKV(ld_, hd_), o[d0], 0, 0, 0); } \
        { s16x4 la_, ha_, lb_, hb_; \
            TR_READ(la_, vb, DL_VOFF(KB0, 8, 0, d0)); TR_READ(ha_, vb, DL_VOFF(KB0, 8, 1, d0)); TR_READ(lb_, vb, DL_VOFF(KB0, 9, 0, d0)); TR_READ(hb_, vb, DL_VOFF(KB0, 9, 1, d0)); \
            asm volatile("s_waitcnt lgkmcnt(0)" ::: "memory"); SBAR(); \
            o[d0] = __builtin_amdgcn_mfma_f32_32x32x16_bf16(pa[8], PKV(la_, ha_), o[d0], 0, 0, 0); o[d0] = __builtin_amdgcn_mfma_f32_32x32x16_bf16(pa[9], PKV(lb_, hb_), o[d0], 0, 0, 0); } } } while (0)
__device__ __forceinline__ void dl_unit(bf16_t* proj, float* lse, int g, int dil, int ltok0, int Lsub, int rres, int qc, int h, LAS unsigned char* lds, unsigned lds0) {
    constexpr int LDP = 9216; constexpr int KOFF = 0, VOFF = 49152;
    int tid = threadIdx.x; asm volatile("" : "+v"(tid));
    const int wid = __builtin_amdgcn_readfirstlane(tid >> 6), lane = tid & 63, r32 = lane & 31, hi = lane >> 5;
    const int colQ = g * 3072 + h * 64, colK = colQ + 1024, colV = colQ + 2048;
    const int nl = wid >> 1, qbk = wid & 1;
    const int mq = qc * 256 + nl * 64 + qbk * 32;
    const int mk0 = qc * 256 - 64;
#pragma unroll
    for (int i = 0; i < 6; ++i) { const int L = (i * 8 + wid) * 1024 + lane * 16;
        const int row = L >> 7, pg = (L & 127) >> 4, lg = pg ^ ((row >> 1) & 7); int mk = mk0 + row; mk = mk < 0 ? 0 : (mk >= Lsub ? Lsub - 1 : mk);
        glds16(proj + (size_t)(ltok0 + mk * dil + rres) * LDP + colK + lg * 8, (unsigned)__builtin_amdgcn_readfirstlane(lds0 + KOFF + (i * 8 + wid) * 1024)); }
    bf16x8 qr[4];
    { const bf16_t* Qw = proj + (size_t)(ltok0 + (mq + r32) * dil + rres) * LDP + colQ + hi * 8;
#pragma unroll
      for (int d0 = 0; d0 < 4; ++d0) asm volatile("global_load_dwordx4 %0, %1, off" : "=&v"(qr[d0]) : "v"(Qw + d0 * 16) : "memory"); }
#pragma unroll
    for (int i = 0; i < 6; ++i) { const int L = (i * 8 + wid) * 1024 + lane * 16;
        const int tile = L >> 13, Lt = L & 8191, sub = Lt >> 9, k = (sub >> 1) * 8 + ((Lt & 511) >> 6), col = (sub & 1) * 32 + ((Lt & 63) >> 1);
        int mk = mk0 + tile * 64 + k; mk = mk < 0 ? 0 : (mk >= Lsub ? Lsub - 1 : mk);
        glds16(proj + (size_t)(ltok0 + mk * dil + rres) * LDP + colV + col, (unsigned)__builtin_amdgcn_readfirstlane(lds0 + VOFF + (i * 8 + wid) * 1024)); }
    asm volatile("s_waitcnt vmcnt(6)\n\ts_barrier" : "+v"(qr[0]), "+v"(qr[1]), "+v"(qr[2]), "+v"(qr[3]) :: "memory");
    f32x16 p[5];
#pragma unroll
    for (int kk = 0; kk < 5; ++kk) { p[kk] = f32x16{}; const int krow = nl * 64 + (qbk + kk) * 32 + r32; const int sw = (krow >> 1) & 7;
        bf16x8 kf[4];
#pragma unroll
        for (int d0 = 0; d0 < 4; ++d0) kf[d0] = *(const LAS bf16x8*)(lds + KOFF + krow * 128 + (((2 * d0 + hi) ^ sw) << 4));
        SBAR();
#pragma unroll
        for (int d0 = 0; d0 < 4; ++d0) p[kk] = __builtin_amdgcn_mfma_f32_32x32x16_bf16(kf[d0], qr[d0], p[kk], 0, 0, 0); }
#pragma unroll
    for (int r = 0; r < 16; ++r) { const int c = crow(r, hi); p[0][r] = (c >= r32) ? p[0][r] : -1e30f; p[4][r] = (c <= r32) ? p[4][r] : -1e30f; }
    if (mk0 < 0 || mk0 + 384 > Lsub) {
        const int kpos0 = mk0 + nl * 64 + qbk * 32;
#pragma unroll
        for (int kk = 0; kk < 5; ++kk)
#pragma unroll
            for (int r = 0; r < 16; ++r) { const int kpos = kpos0 + kk * 32 + crow(r, hi); p[kk][r] = (kpos >= 0 && kpos < Lsub) ? p[kk][r] : -1e30f; }
    }
    float pmax = -1e30f;
#pragma unroll
    for (int kk = 0; kk < 5; ++kk)
#pragma unroll
        for (int r = 0; r < 16; ++r) pmax = fmaxf(pmax, p[kk][r]);
    { auto rr = __builtin_amdgcn_permlane32_swap(__float_as_uint(pmax), __float_as_uint(pmax), false, false); pmax = fmaxf(__uint_as_float(rr[0]), __uint_as_float(rr[1])); }
    float ps = 0.f;
#pragma unroll
    for (int kk = 0; kk < 5; ++kk)
#pragma unroll
        for (int r = 0; r < 16; ++r) { p[kk][r] = __builtin_amdgcn_exp2f(p[kk][r] - pmax); ps += p[kk][r]; }
    { auto rr = __builtin_amdgcn_permlane32_swap(__float_as_uint(ps), __float_as_uint(ps), false, false); ps = __uint_as_float(rr[0]) + __uint_as_float(rr[1]); }
    if (hi == 0) lse[((size_t)g * 16384 + (size_t)(ltok0 + (mq + r32) * dil + rres)) * 16 + h] = pmax + __builtin_amdgcn_logf(ps);
    bf16x8 pa[10];
#pragma unroll
    for (int kk = 0; kk < 5; ++kk) { PK4(p[kk], 0, pa[2 * kk]); PK4(p[kk], 8, pa[2 * kk + 1]); }
    f32x16 o[2]; o[0] = f32x16{}; o[1] = f32x16{};
    const int vb = (int)lds0 + VOFF + nl * 8192 + v_rd_base(lane);
    WAIT_BAR();
    if (qbk == 0) DL_PV(0); else DL_PV(1);
    LAS float* wsf = (LAS float*)(lds + 98304) + wid * 64;
    if (hi == 0) wsf[r32] = 1.f / ps;
    asm volatile("s_waitcnt lgkmcnt(0)" ::: "memory");
    LAS bf16_t* stg = (LAS bf16_t*)(lds + KOFF + wid * 4096);
#pragma unroll
    for (int r = 0; r < 16; ++r) { const float ri = wsf[crow(r, hi)];
#pragma unroll
        for (int d0 = 0; d0 < 2; ++d0) stg[crow(r, hi) * 64 + d0 * 32 + r32] = (bf16_t)(cvt_pk_bf16(o[d0][r] * ri, 0.f) & 0xffffu); }
    asm volatile("s_waitcnt lgkmcnt(0)" ::: "memory");
#pragma unroll
    for (int i = 0; i < 4; ++i) { const int p = i * 64 + lane, row = p >> 3, ch = p & 7;
        const u32x4 v = *(const LAS u32x4*)(stg + row * 64 + ch * 8);
        *(u32x4*)(proj + (size_t)(ltok0 + (mq + row) * dil + rres) * LDP + colQ + ch * 8) = v; }
    WAIT_BAR();
}

__device__ __forceinline__ void da_decode(int i, int x, int jj, int& tok0, int& seq, int& h, int& qb) {
    if (i < 8) { const int sh = (i >> 1) * 8 + x; tok0 = (sh >> 3) * 8192; seq = 8192; h = sh & 7; qb = jj + 32 * (i & 1); }
    else { const int sh = (i - 8) * 8 + x; tok0 = TP + (sh >> 3) * 4096; seq = 4096; h = sh & 7; qb = jj; }
}
__global__ void __launch_bounds__(512, 2) fwd_mega(Params P) {
    extern __shared__ __attribute__((aligned(16))) unsigned char lds_raw[];
    cg::grid_group grid = cg::this_grid();
    LAS unsigned char* lds = (LAS unsigned char*)lds_raw;
    const unsigned lds0 = (unsigned)(uintptr_t)lds_raw;
    unsigned char* ws = P.ws;
    float* X = P.out;
    const bf16_t* XS = (const bf16_t*)P.out + (size_t)T * DM;
    bf16_t* BIG = (bf16_t*)(ws + WS_BIG);
    const float* rope = (const float*)(ws + WS_ROPE);
    const int bx = blockIdx.x; __builtin_assume(bx >= 0 && bx < NG);

    if (threadIdx.x < 2) ((volatile LAS unsigned*)(lds + LDS_TAB + 1024))[threadIdx.x] = 0u;
    __syncthreads();
    if (blockIdx.x == 0) for (int w = threadIdx.x; w < 4096; w += 512) ((unsigned*)(ws + WS_BAR))[w] = 0u;
    prologue(P, lds);
    grid.sync();
    (void)xcd_barrier_post((unsigned*)(ws + WS_BAR), (volatile LAS unsigned*)(lds + LDS_TAB + 1024));
#define GSYNC() do { XcdBarrier xb_; xb_.bar = (unsigned*)(P.ws + WS_BAR); xb_.x = xb_xcc_id(); xb_.st = (volatile LAS unsigned*)(lds + LDS_TAB + 1024); xcd_barrier(xb_); } while (0)

    for (int layer = 0; layer < 4; ++layer) {
        const int jl = layer >> 1;
        if ((layer & 1) == 0) {
            { pg8::SchedDense S; S.init(T, 3072, NG, bx, XS, DM, (bf16_t*)(ws + W_DAIN) + (size_t)jl * 3072 * 1024, DM);
              pg8::EpiProj E{BIG, 3072, rope, 0};
              pg8::gemm_phase<true>(lds, DM, DM, DM, S, E); }
            GSYNC();
            {
                const float lambda_init = 0.8f - 0.6f * expf(-0.3f * (float)layer);
                float d1 = 0.f, d2 = 0.f;
                for (int k = 0; k < 64; ++k) { d1 += P.in[4][jl * 64 + k] * P.in[5][jl * 64 + k]; d2 += P.in[6][jl * 64 + k] * P.in[7][jl * 64 + k]; }
                const float lam = expf(d1) - expf(d2) + lambda_init;
                const float* subg = P.in[8] + jl * 128;
                const int x = bx & 7, jj = bx >> 3;
                bf16x8 qn[4];
                for (int i = 0; i < 12; ++i) {
                    int tok0, seq, h, qb, ntok0, nseq, nh, nqb;
                    da_decode(i, x, jj, tok0, seq, h, qb); da_decode(i < 11 ? i + 1 : i, x, jj, ntok0, nseq, nh, nqb);
                    da_unit(BIG, tok0, seq, h, qb, ntok0, nh, nqb, i == 0, i < 11, qn, lam, subg, 1.f - lambda_init, lds, lds0);
                }
            }
            GSYNC();
            { pg8::SchedDense S; S.init(T, DM, NG, bx, BIG, 3072, (bf16_t*)(ws + W_DAOUT) + (size_t)jl * 1024 * 1024, DM);
              pg8::EpiRes E{(const unsigned short*)P.out + (size_t)T * DM, (unsigned short*)P.out, 0};
              pg8::gemm_phase<false>(lds, DM, 3072, DM, S, E); }
            GSYNC();
        } else {
            float* lse = (float*)(ws + WS_LSE);
            for (int ch = 0; ch < 3; ++ch) {
                { pg8::SchedDense S; S.init(16384, 9216, NG, bx, XS + (size_t)ch * 16384 * DM, DM, (bf16_t*)(ws + W_DLIN) + (size_t)jl * 9216 * 1024, DM);
                  pg8::EpiProj E{BIG, 9216, rope, ch * 16384};
                  pg8::gemm_phase<true>(lds, DM, DM, DM, S, E); }
                GSYNC();
                {
                    const int Sq = (ch < 2) ? 8192 : 4096, spc = Sq >> 8;
                    for (int i = 0; i < 12; ++i) {
                        const int u = i * NG + bx, h = u & 15, rest = u >> 4, g = rest >> 6, cm = rest & 63;
                        const int sl = cm / spc, idx = cm % spc, dil = (g == 0) ? 1 : (g == 1 ? 4 : 16), Lsub = Sq / dil, cps = Lsub >> 8;
                        const int rres = idx / cps, qc = idx % cps;
                        dl_unit(BIG, lse, g, dil, sl * Sq, Lsub, rres, qc, h, lds, lds0);
                    }
                }
                GSYNC();
                int tidc = threadIdx.x; asm volatile("" : "+v"(tidc));
                for (int idx = bx * 512 + tidc; idx < 16384 * 128; idx += NG * 512) {
                    const int tl = idx >> 7, c8 = idx & 127, hh = c8 >> 3;
                    const float l0 = lse[((size_t)0 * 16384 + tl) * 16 + hh], l1 = lse[((size_t)1 * 16384 + tl) * 16 + hh], l2 = lse[((size_t)2 * 16384 + tl) * 16 + hh];
                    const float mx = fmaxf(l0, fmaxf(l1, l2));
                    float w0 = __builtin_amdgcn_exp2f(l0 - mx), w1 = __builtin_amdgcn_exp2f(l1 - mx), w2 = __builtin_amdgcn_exp2f(l2 - mx);
                    const float inv = 1.f / (w0 + w1 + w2); w0 *= inv; w1 *= inv; w2 *= inv;
                    const u32x4 a = *(const u32x4*)(BIG + (size_t)tl * 9216 + c8 * 8), b = *(const u32x4*)(BIG + (size_t)tl * 9216 + 3072 + c8 * 8), c = *(const u32x4*)(BIG + (size_t)tl * 9216 + 6144 + c8 * 8);
                    u32x4 o;
#pragma unroll
                    for (int e = 0; e < 4; ++e) {
                        const float lo = w0 * __uint_as_float(a[e] << 16) + w1 * __uint_as_float(b[e] << 16) + w2 * __uint_as_float(c[e] << 16);
                        const float hi_ = w0 * __uint_as_float(a[e] & 0xffff0000u) + w1 * __uint_as_float(b[e] & 0xffff0000u) + w2 * __uint_as_float(c[e] & 0xffff0000u);
                        o[e] = cvt_pk_bf16(lo, hi_); }
                    *(u32x4*)(BIG + (size_t)tl * 9216 + c8 * 8) = o;
                }
                GSYNC();
                { pg8::SchedDense S; S.init(16384, DM, NG, bx, BIG, 9216, (bf16_t*)(ws + W_DLOUT) + (size_t)jl * 1024 * 1024, DM);
                  pg8::EpiRes E{(const unsigned short*)P.out + (size_t)T * DM, (unsigned short*)P.out, ch * 16384};
                  pg8::gemm_phase<false>(lds, DM, 9216, DM, S, E); }
                GSYNC();
            }
        }
        phase_ln1_router(P, layer, lds);
        GSYNC();
        phase_gather(P, layer, lds);
        GSYNC();
        { const char* strm = (layer == 3) ? (const char*)(ws + WS_XB) : (const char*)((const bf16_t*)P.out + (size_t)T * DM);
          pg8::SchedMoE<true> S{(LAS int*)(lds + LDS_TAB + 4096), (const int*)(ws + WS_ROWI), (const LAS int*)(lds + LDS_TAB), NG, bx, strm, (const char*)((bf16_t*)(ws + W_GU) + (size_t)layer * 16 * 1024 * 1024),
                          (size_t)0, (size_t)256 * DM * 2, (size_t)1024 * 1024 * 2};
          pg8::EpiGU E{(bf16_t*)(ws + BIG_H), (const float*)(ws + WS_ROWW)};
          pg8::gemm_phase<true>(lds, DM, DM, DM, S, E); }
        GSYNC();
        { pg8::SchedMoE<false> S{nullptr, nullptr, (const LAS int*)(lds + LDS_TAB), NG, bx, (const char*)(ws + BIG_H), (const char*)((bf16_t*)(ws + W_DN) + (size_t)layer * 16 * 1024 * 512),
                          (size_t)256 * 512 * 2, (size_t)256 * 512 * 2, (size_t)1024 * 512 * 2};
          pg8::EpiDown E{BIG, (const int*)(ws + WS_ROWI)};
          pg8::gemm_phase<false>(lds, 512, 512, 512, S, E); }
        GSYNC();
        phase_ln2(P, layer);
        GSYNC();
    }
}

extern "C" void kernel_launch(void* const* d_in, const int* in_sizes, int n_in, void* d_out, int out_size, void* d_ws, size_t ws_size, hipStream_t stream) {
    static int ready = 0;
    if (ready == 0) {
        if (n_in != 20 || out_size != T * DM || ws_size < WS_END) { fprintf(stderr, "kernel_launch: unexpected shapes (n_in %d out %d ws %zu, need %zu)\n", n_in, out_size, ws_size, (size_t)WS_END); ready = -1; return; }
        if (hipFuncSetAttribute((const void*)fwd_mega, hipFuncAttributeMaxDynamicSharedMemorySize, LDS_BYTES) != hipSuccess) { fprintf(stderr, "kernel_launch: hipFuncSetAttribute failed\n"); ready = -1; return; }
        int per_cu = 0;
        if (hipOccupancyMaxActiveBlocksPerMultiprocessor(&per_cu, (const void*)fwd_mega, 512, LDS_BYTES) != hipSuccess || per_cu < 1) fprintf(stderr, "kernel_launch: occupancy query says %d\n", per_cu);
        (void)hipGetLastError();
        ready = 1;
    }
    if (ready < 0) return;
    Params p{};
    for (int i = 0; i < 20; ++i) p.in[i] = (const float*)d_in[i];
    p.out = (float*)d_out; p.ws = (unsigned char*)d_ws;
    void* args[] = {&p};
    hipError_t e = hipLaunchCooperativeKernel((const void*)fwd_mega, dim3(NG), dim3(512), args, LDS_BYTES, stream);
    if (e != hipSuccess) fprintf(stderr, "cooperative launch failed: %s\n", hipGetErrorString(e));
}
```
